# Optimizing an MI355X kernel written in HIP

```python
import math
import jax, jax.numpy as jnp
from jax import lax
import numpy as np

D_MODEL = 2048
BATCH = 1
SEQ = 8192
DEPTH = 4

N_META = 16
CHUNK = 128
BRANCH_WIDTH = D_MODEL // 2
RET_HEADS = 8
RET_DK = BRANCH_WIDTH // RET_HEADS
RET_DV = BRANCH_WIDTH // RET_HEADS
ROPE_BASE = 10000.0
GLA_HEADS = 4
GLA_DK = BRANCH_WIDTH // 2 // GLA_HEADS
GLA_DV = BRANCH_WIDTH // GLA_HEADS
GLA_RANK = 16
GLA_GATE_NORMALIZER = 16.0
S5_WIDTH = BRANCH_WIDTH
S5_GROUP = 16
S5_GROUPS = S5_WIDTH // S5_GROUP
S5_STATE = 64
N_BRANCH = 3
NORM_EPS = 1e-6

IN_SPLITS = (
    RET_HEADS * RET_DK,
    RET_HEADS * RET_DK,
    RET_HEADS * RET_DV,
    BRANCH_WIDTH,
    GLA_HEADS * GLA_DK,
    GLA_HEADS * GLA_DK,
    GLA_HEADS * GLA_DV,
    BRANCH_WIDTH,
    GLA_RANK,
    S5_WIDTH,
    S5_WIDTH,
    N_BRANCH * D_MODEL,
)
N_IN = sum(IN_SPLITS)

kernel_name = "hybrid_retention_gla_s5_meta"


def rmsnorm(x, g):
    xf = x.astype(jnp.float32)
    y = xf * lax.rsqrt(jnp.mean(xf * xf, axis=-1, keepdims=True) + NORM_EPS)
    return (y * g.astype(jnp.float32)).astype(x.dtype)


def rotary(t, pos):
    half = t.shape[-1] // 2
    inv = ROPE_BASE ** (-jnp.arange(half, dtype=jnp.float32) / half)
    ang = pos[:, None] * inv[None, :]
    cos = jnp.cos(ang)[None, :, None, :]
    sin = jnp.sin(ang)[None, :, None, :]
    t1, t2 = t[..., :half], t[..., half:]
    return jnp.concatenate([t1 * cos - t2 * sin, t1 * sin + t2 * cos], axis=-1)


def to_chunks(t):
    pad = CHUNK - N_META
    t = jnp.pad(t, [(0, 0), (pad, 0)] + [(0, 0)] * (t.ndim - 2))
    return t.reshape(t.shape[0], -1, CHUNK, *t.shape[2:])


def from_chunks(t):
    t = t.reshape(t.shape[0], -1, *t.shape[3:])
    return t[:, CHUNK - N_META:]


def chunk_state_scan(decay, kv):
    def step(s, inp):
        d, u = inp
        return d[..., None] * s + u, s
    s0 = jnp.zeros_like(kv[:, 0])
    _, prev = lax.scan(step, s0, (jnp.moveaxis(decay, 1, 0), jnp.moveaxis(kv, 1, 0)))
    return jnp.moveaxis(prev, 0, 1)


def retention(q, k, v):
    nh = q.shape[2]
    log_gamma = jnp.log1p(-jnp.exp2(-5.0 - jnp.arange(nh, dtype=jnp.float32)))
    idx = jnp.arange(CHUNK, dtype=jnp.float32)
    rel = idx[:, None] - idx[None, :]
    dmat = jnp.where(rel >= 0, jnp.exp(log_gamma[:, None, None] * jnp.maximum(rel, 0.0)), 0.0)
    qc, kc, vc = to_chunks(q), to_chunks(k), to_chunks(v)
    scores = jnp.einsum('bnchd,bnshd->bnhcs', qc, kc) * dmat
    out = jnp.einsum('bnhcs,bnshv->bnchv', scores, vc)
    k_dec = jnp.exp(log_gamma[:, None] * (CHUNK - 1 - idx)[None, :])
    kv = jnp.einsum('bnshd,hs,bnshv->bnhdv', kc, k_dec, vc)
    decay = jnp.broadcast_to(jnp.exp(log_gamma * CHUNK)[None, None, :, None], kv.shape[:-1])
    prev = chunk_state_scan(decay, kv)
    q_dec = jnp.exp(log_gamma[:, None] * (idx + 1.0)[None, :])
    out = out + jnp.einsum('bnchd,hc,bnhdv->bnchv', qc, q_dec, prev)
    return from_chunks(out)


def gla(q, k, v, log_a):
    qc, kc, vc, ac = to_chunks(q), to_chunks(k), to_chunks(v), to_chunks(log_a)
    b = jnp.cumsum(ac, axis=2)
    q_in = qc * jnp.exp(b)
    k_in = kc * jnp.exp(-b)
    scores = jnp.einsum('bnchd,bnshd->bnhcs', q_in, k_in)
    mask = jnp.tril(jnp.ones((CHUNK, CHUNK), dtype=bool))
    scores = jnp.where(mask, scores, 0.0)
    out = jnp.einsum('bnhcs,bnshv->bnchv', scores, vc)
    b_last = b[:, :, -1]
    kv = jnp.einsum('bnshd,bnshv->bnhdv', kc * jnp.exp(b_last[:, :, None] - b), vc)
    prev = chunk_state_scan(jnp.exp(b_last), kv)
    out = out + jnp.einsum('bnchd,bnhdv->bnchv', q_in, prev)
    return from_chunks(out)


def complex_affine_combine(e1, e2):
    a1r, a1i, b1r, b1i = e1
    a2r, a2i, b2r, b2i = e2
    return (a2r * a1r - a2i * a1i,
            a2r * a1i + a2i * a1r,
            a2r * b1r - a2i * b1i + b2r,
            a2r * b1i + a2i * b1r + b2i)


def s5_ssm(u, lam_re, lam_im, log_dt, b_re, b_im, c_re, c_im, d):
    bsz, length, _ = u.shape
    dt = jnp.exp(log_dt)[:, None]
    mag = jnp.exp(lam_re * dt)
    abar_re = mag * jnp.cos(lam_im * dt)
    abar_im = mag * jnp.sin(lam_im * dt)
    den = lam_re * lam_re + lam_im * lam_im
    nr = abar_re - 1.0
    ni = abar_im
    f_re = (nr * lam_re + ni * lam_im) / den
    f_im = (ni * lam_re - nr * lam_im) / den
    bb_re = f_re[..., None] * b_re - f_im[..., None] * b_im
    bb_im = f_re[..., None] * b_im + f_im[..., None] * b_re
    ug = u.reshape(bsz, length, S5_GROUPS, S5_GROUP)
    bu_re = jnp.einsum('blgc,gpc->blgp', ug, bb_re)
    bu_im = jnp.einsum('blgc,gpc->blgp', ug, bb_im)
    a_re = jnp.broadcast_to(abar_re, bu_re.shape)
    a_im = jnp.broadcast_to(abar_im, bu_im.shape)
    _, _, h_re, h_im = lax.associative_scan(complex_affine_combine, (a_re, a_im, bu_re, bu_im), axis=1)
    y = jnp.einsum('blgp,gcp->blgc', h_re, c_re) - jnp.einsum('blgp,gcp->blgc', h_im, c_im)
    return y.reshape(bsz, length, S5_WIDTH) + d * u


def hybrid_layer(h_res, pos, norm_g, w_in, ret_norm_g, gla_w_a, gla_b_a, gla_norm_g,
                 s5_lambda_re, s5_lambda_im, s5_log_dt, s5_b_re, s5_b_im, s5_c_re, s5_c_im, s5_d,
                 s5_w_glu, w_br_ret, w_br_gla, w_br_s5, w_out):
    f32 = jnp.float32
    dt = h_res.dtype
    bsz, length, _ = h_res.shape
    h = rmsnorm(h_res, norm_g)
    proj = h @ w_in
    offs = [int(o) for o in np.cumsum(IN_SPLITS)[:-1]]
    (rq, rk, rv, rg, gq, gk, gv, gg, glr, su, sg, mg) = jnp.split(proj, offs, axis=-1)

    rq = rotary(rq.reshape(bsz, length, RET_HEADS, RET_DK).astype(f32), pos)
    rk = rotary(rk.reshape(bsz, length, RET_HEADS, RET_DK).astype(f32), pos) * (RET_DK ** -0.5)
    ro = retention(rq, rk, rv.reshape(bsz, length, RET_HEADS, RET_DV).astype(f32))
    mu = jnp.mean(ro, axis=-1, keepdims=True)
    var = jnp.mean(jnp.square(ro - mu), axis=-1, keepdims=True)
    ro = ((ro - mu) * lax.rsqrt(var + NORM_EPS)).reshape(bsz, length, BRANCH_WIDTH) * ret_norm_g.astype(f32)
    ro = (ro * jax.nn.silu(rg.astype(f32))).astype(dt)

    log_a = jax.nn.log_sigmoid((glr @ gla_w_a + gla_b_a).astype(f32)) / GLA_GATE_NORMALIZER
    go = gla(gq.reshape(bsz, length, GLA_HEADS, GLA_DK).astype(f32) * (GLA_DK ** -0.5),
             gk.reshape(bsz, length, GLA_HEADS, GLA_DK).astype(f32),
             gv.reshape(bsz, length, GLA_HEADS, GLA_DV).astype(f32),
             log_a.reshape(bsz, length, GLA_HEADS, GLA_DK))
    go = go * lax.rsqrt(jnp.mean(go * go, axis=-1, keepdims=True) + NORM_EPS) * gla_norm_g.astype(f32)
    go = (go.reshape(bsz, length, BRANCH_WIDTH) * jax.nn.silu(gg.astype(f32))).astype(dt)

    so = s5_ssm(su.astype(f32), s5_lambda_re.astype(f32), s5_lambda_im.astype(f32), s5_log_dt.astype(f32),
                s5_b_re.astype(f32), s5_b_im.astype(f32), s5_c_re.astype(f32), s5_c_im.astype(f32),
                s5_d.astype(f32))
    so = jax.nn.gelu(so)
    so = so * jax.nn.sigmoid(so @ s5_w_glu.astype(f32))
    so = (so * jax.nn.silu(sg.astype(f32))).astype(dt)

    g_r, g_g, g_s = jnp.split(mg, N_BRANCH, axis=-1)
    y = (jax.nn.sigmoid(g_r) * (ro @ w_br_ret)
         + jax.nn.sigmoid(g_g) * (go @ w_br_gla)
         + jax.nn.sigmoid(g_s) * (so @ w_br_s5))
    return h_res + y @ w_out


def setup_inputs(seed: int = 0) -> dict:
    key = jax.random.key(seed)
    ks = jax.random.split(key, 24)
    f32 = jnp.float32
    nrm = lambda k, shape, scale: jax.random.normal(k, shape, f32) * scale
    x = nrm(ks[0], (BATCH, SEQ, D_MODEL), 1.0)
    meta = nrm(ks[1], (N_META, D_MODEL), 1.0)
    norm_g = 1.0 + nrm(ks[2], (DEPTH, D_MODEL), 0.01)
    w_in = nrm(ks[3], (DEPTH, D_MODEL, N_IN), D_MODEL ** -0.5)
    ret_norm_g = 1.0 + nrm(ks[4], (DEPTH, BRANCH_WIDTH), 0.01)
    gla_w_a = nrm(ks[5], (DEPTH, GLA_RANK, GLA_HEADS * GLA_DK), GLA_RANK ** -0.5)
    gla_b_a = nrm(ks[6], (DEPTH, GLA_HEADS * GLA_DK), 0.01)
    gla_norm_g = 1.0 + nrm(ks[7], (DEPTH, GLA_DV), 0.01)
    s5_lambda_re = -0.5 + nrm(ks[8], (DEPTH, S5_GROUPS, S5_STATE), 0.01)
    s5_lambda_im = math.pi * jnp.arange(S5_STATE, dtype=f32) + nrm(ks[9], (DEPTH, S5_GROUPS, S5_STATE), 0.01)
    s5_log_dt = jax.random.uniform(ks[10], (DEPTH, S5_GROUPS), f32, math.log(1e-3), math.log(1e-1))
    bscale = (2.0 * S5_GROUP) ** -0.5
    s5_b_re = nrm(ks[11], (DEPTH, S5_GROUPS, S5_STATE, S5_GROUP), bscale)
    s5_b_im = nrm(ks[12], (DEPTH, S5_GROUPS, S5_STATE, S5_GROUP), bscale)
    cscale = (2.0 * S5_STATE) ** -0.5
    s5_c_re = nrm(ks[13], (DEPTH, S5_GROUPS, S5_GROUP, S5_STATE), cscale)
    s5_c_im = nrm(ks[14], (DEPTH, S5_GROUPS, S5_GROUP, S5_STATE), cscale)
    s5_d = nrm(ks[15], (DEPTH, S5_WIDTH), 1.0)
    s5_w_glu = nrm(ks[16], (DEPTH, S5_WIDTH, S5_WIDTH), S5_WIDTH ** -0.5)
    w_br_ret = nrm(ks[17], (DEPTH, BRANCH_WIDTH, D_MODEL), BRANCH_WIDTH ** -0.5)
    w_br_gla = nrm(ks[18], (DEPTH, BRANCH_WIDTH, D_MODEL), BRANCH_WIDTH ** -0.5)
    w_br_s5 = nrm(ks[19], (DEPTH, S5_WIDTH, D_MODEL), S5_WIDTH ** -0.5)
    w_out = nrm(ks[20], (DEPTH, D_MODEL, D_MODEL), D_MODEL ** -0.5)
    final_g = 1.0 + nrm(ks[21], (D_MODEL,), 0.01)
    return {"x": x, "meta": meta, "norm_g": norm_g, "w_in": w_in, "ret_norm_g": ret_norm_g,
            "gla_w_a": gla_w_a, "gla_b_a": gla_b_a, "gla_norm_g": gla_norm_g,
            "s5_lambda_re": s5_lambda_re, "s5_lambda_im": s5_lambda_im, "s5_log_dt": s5_log_dt,
            "s5_b_re": s5_b_re, "s5_b_im": s5_b_im, "s5_c_re": s5_c_re, "s5_c_im": s5_c_im,
            "s5_d": s5_d, "s5_w_glu": s5_w_glu, "w_br_ret": w_br_ret, "w_br_gla": w_br_gla,
            "w_br_s5": w_br_s5, "w_out": w_out, "final_g": final_g}


def reference(x, meta, norm_g, w_in, ret_norm_g, gla_w_a, gla_b_a, gla_norm_g,
              s5_lambda_re, s5_lambda_im, s5_log_dt, s5_b_re, s5_b_im, s5_c_re, s5_c_im,
              s5_d, s5_w_glu, w_br_ret, w_br_gla, w_br_s5, w_out, final_g):
    bsz = x.shape[0]
    meta_b = jnp.broadcast_to(meta[None].astype(x.dtype), (bsz, N_META, D_MODEL))
    h = jnp.concatenate([meta_b, x], axis=1)
    pos = jnp.arange(h.shape[1], dtype=jnp.float32)
    for l in range(DEPTH):
        h = hybrid_layer(h, pos, norm_g[l], w_in[l], ret_norm_g[l], gla_w_a[l], gla_b_a[l], gla_norm_g[l],
                         s5_lambda_re[l], s5_lambda_im[l], s5_log_dt[l], s5_b_re[l], s5_b_im[l],
                         s5_c_re[l], s5_c_im[l], s5_d[l], s5_w_glu[l], w_br_ret[l], w_br_gla[l],
                         w_br_s5[l], w_out[l])
    h = rmsnorm(h, final_g)
    return h[:, N_META:]
```

```cpp
#include <hip/hip_runtime.h>
#include <hip/hip_cooperative_groups.h>
#include <cstdio>
namespace cg = cooperative_groups;

#define LAS __attribute__((address_space(3)))
typedef unsigned short bf16_t;
typedef short bf16x8 __attribute__((ext_vector_type(8)));
typedef short s16x4 __attribute__((ext_vector_type(4)));
typedef float f32x4 __attribute__((ext_vector_type(4)));
typedef unsigned u32x4 __attribute__((ext_vector_type(4)));
typedef unsigned u32x2 __attribute__((ext_vector_type(2)));

constexpr int DM = 2048, SEQ = 8192, DEPTH = 4;
constexpr int ROW0 = 240;
constexpr int MR = 8448;
constexpr int NCH = 66;
constexpr int NIN_SRC = 15376;
constexpr int NIN_T = 15616;
constexpr int PLD = 15360;
constexpr int C_RQ = 0, C_RK = 1024, C_RV = 2048, C_RG = 3072, C_GQ = 4096, C_GK = 4608, C_GV = 5120, C_GG = 6144, C_SU = 7168, C_SG = 8192, C_MG = 9216;
constexpr float EPS = 1e-6f;
constexpr int NT = 512;
constexpr int LDS_BYTES = 155648;

constexpr size_t al256(size_t x) { return (x + 255) & ~(size_t)255; }
constexpr size_t WS_H = 0;
constexpr size_t WS_HN = WS_H + al256((size_t)MR * DM * 4);
constexpr size_t WS_PROJ = WS_HN + al256((size_t)MR * DM * 2);
constexpr size_t WS_GLR = WS_PROJ + al256((size_t)MR * PLD * 2);
constexpr size_t WS_WIN = WS_GLR + al256((size_t)MR * 16 * 4);
constexpr size_t WS_WGLU = WS_WIN + al256((size_t)DEPTH * NIN_T * DM * 2);
constexpr size_t WS_WBR = WS_WGLU + al256((size_t)DEPTH * 1024 * 1024 * 2);
constexpr size_t WS_WOUT = WS_WBR + al256((size_t)DEPTH * 3 * 2048 * 1024 * 2);
constexpr size_t WS_COS = WS_WOUT + al256((size_t)DEPTH * 2048 * 2048 * 2);
constexpr size_t WS_SIN = WS_COS + al256((size_t)MR * 64 * 4);
constexpr size_t WS_RKV = WS_SIN + al256((size_t)MR * 64 * 4);
constexpr size_t WS_RPREV = WS_RKV + al256((size_t)NCH * 8 * 128 * 128 * 4);
constexpr size_t WS_GKV = WS_RPREV + al256((size_t)NCH * 8 * 128 * 128 * 2);
constexpr size_t WS_GPREV = WS_GKV + al256((size_t)NCH * 4 * 128 * 256 * 4);
constexpr size_t WS_GDEC = WS_GPREV + al256((size_t)NCH * 4 * 128 * 256 * 2);
constexpr size_t WS_S5E = WS_GDEC + al256((size_t)NCH * 4 * 128 * 4);
constexpr size_t WS_S5H = WS_S5E + al256((size_t)NCH * 64 * 64 * 2 * 4);
constexpr size_t WS_RO = WS_S5H + al256((size_t)NCH * 64 * 64 * 2 * 4);
constexpr size_t WS_GO = WS_RO + al256((size_t)MR * 1024 * 2);
constexpr size_t WS_SO = WS_GO + al256((size_t)MR * 1024 * 2);
constexpr size_t WS_SOPRE = WS_SO + al256((size_t)MR * 1024 * 2);
constexpr size_t WS_Y = WS_SOPRE + al256((size_t)MR * 1024 * 2);
constexpr size_t WS_YACC = WS_Y + al256((size_t)MR * DM * 2);
constexpr size_t WS_END = WS_YACC + al256((size_t)MR * DM * 4);

struct Params {
    const float* x; const float* meta; const float* norm_g; const float* w_in; const float* ret_norm_g;
    const float* gla_w_a; const float* gla_b_a; const float* gla_norm_g;
    const float* s5_lre; const float* s5_lim; const float* s5_logdt; const float* s5_bre; const float* s5_bim; const float* s5_cre; const float* s5_cim;
    const float* s5_d; const float* s5_wglu; const float* w_br_ret; const float* w_br_gla; const float* w_br_s5; const float* w_out; const float* final_g;
    float* out; unsigned char* ws;
};

__device__ __forceinline__ unsigned cvt_pk_bf16(float lo, float hi) { unsigned r; asm("v_cvt_pk_bf16_f32 %0, %1, %2" : "=v"(r) : "v"(lo), "v"(hi)); return r; }
__device__ __forceinline__ bf16_t f2bf(float f) { return (bf16_t)(cvt_pk_bf16(f, 0.f) & 0xffffu); }
__device__ __forceinline__ float bf2f(bf16_t b) { return __uint_as_float(((unsigned)b) << 16); }
__device__ __forceinline__ float bflo(unsigned w) { return __uint_as_float(w << 16); }
__device__ __forceinline__ float bfhi(unsigned w) { return __uint_as_float(w & 0xffff0000u); }
__device__ __forceinline__ float sigmoidf_(float x) { return 1.0f / (1.0f + __expf(-x)); }
__device__ __forceinline__ float siluf_(float x) { return x / (1.0f + __expf(-x)); }
__device__ __forceinline__ float logsigmoidf_(float x) { return fminf(x, 0.f) - log1pf(__expf(-fabsf(x))); }
__device__ __forceinline__ float geluf_(float x) { const float z = 0.7978845608028654f * (x + 0.044715f * x * x * x); const float t = 1.0f - 2.0f / (__expf(2.0f * z) + 1.0f); return 0.5f * x * (1.0f + t); }
__device__ __forceinline__ void sincos_red(float ang, float& s, float& c) {
    const float n = rintf(ang * 0.15915494309189535f);
    float r = fmaf(-n, 6.2831854820251465f, ang);
    r = fmaf(-n, -1.7484556000744883e-7f, r);
    const float rev = r * 0.15915494309189535f;
    s = __builtin_amdgcn_sinf(rev); c = __builtin_amdgcn_cosf(rev);
}
__device__ __forceinline__ float ret_log_gamma(int h) { return log1pf(-exp2f(-5.0f - (float)h)); }

__device__ __forceinline__ bf16x8 frag_row(const LAS unsigned char* img, int pitch, int r0, int k0, int lane) {
    return *(const LAS bf16x8*)(img + (r0 + (lane & 15)) * pitch + (k0 + 8 * (lane >> 4)) * 2);
}
__device__ __forceinline__ bf16x8 frag_tr(const LAS unsigned char* img, int pitch, int k0, int c0, int lane) {
    const int g = lane >> 4, q = (lane & 15) >> 2, p = lane & 3;
    const LAS unsigned char* a = img + (k0 + 8 * g + q) * pitch + (c0 + 4 * p) * 2;
    const s16x4 lo = __builtin_amdgcn_ds_read_tr16_b64_v4i16((LAS s16x4*)a);
    const s16x4 hi = __builtin_amdgcn_ds_read_tr16_b64_v4i16((LAS s16x4*)(a + 4 * pitch));
    bf16x8 r; r[0] = lo[0]; r[1] = lo[1]; r[2] = lo[2]; r[3] = lo[3]; r[4] = hi[0]; r[5] = hi[1]; r[6] = hi[2]; r[7] = hi[3]; return r;
}
__device__ __forceinline__ int tidx() { int t = (int)__builtin_amdgcn_workitem_id_x(); asm volatile("" : "+v"(t)); return t; }
#define MFMA16(a, b, c) __builtin_amdgcn_mfma_f32_16x16x32_bf16((a), (b), (c), 0, 0, 0)

namespace pg8 {
constexpr int BM = 256, BK = 64, HALF = 128, HTB = HALF * BK * 2, STAGE_BYTES = 8 * HTB, NXCD = 8, WGM = 8;
__host__ __device__ __forceinline__ int lds_byte(int r, int c) { const int st = (r >> 4) * 2 + (c >> 5), rr = r & 15, cc = c & 31, ob = rr * 64 + cc * 2; return st * 1024 + (ob ^ (((ob >> 9) & 1) << 5)); }
__host__ __device__ __forceinline__ void stage_rc(int b, int& R, int& C) { const int st = b / 1024, sb = b % 1024, swz = sb ^ (((sb >> 9) & 1) << 5); R = (st >> 1) * 16 + swz / 64; C = (st & 1) * 32 + (swz % 64) / 2; }
__host__ __device__ __forceinline__ int perm32(int rho) { const int n = rho >> 4, i = rho & 15; return 8 * (i >> 2) + 4 * n + (i & 3); }

struct Unit { int pm, pn, sel; };
struct Gemm { const bf16_t* A; const bf16_t* Bt; size_t selA, selB; int M, N, K; };
__device__ __forceinline__ const char* selA(const Gemm& g, int s) { return (const char*)g.A + (size_t)s * g.selA; }
__device__ __forceinline__ const char* selB(const Gemm& g, int s) { return (const char*)g.Bt + (size_t)s * g.selB; }

struct StaticOrder {
    int nM, nN, nwg, G, c, nsel;
    __device__ void init(int M, int N, int G_, int c_, int nsel_) { nM = M / BM; nN = N / BM; nwg = nM * nN; G = G_; c = c_; nsel = nsel_; }
    __device__ bool next(int i, Unit& u) const {
        const int it = i / nsel; u.sel = i - it * nsel;
        const long L = (long)it * G + c; if (L >= nwg) return false;
        int wgid = (int)L; { const int q = nwg / NXCD, r = nwg % NXCD, xcd = wgid % NXCD, off = wgid / NXCD; wgid = (xcd < r ? xcd * (q + 1) : r * (q + 1) + (xcd - r) * q) + off; }
        const int nig = WGM * nN, gid = wgid / nig, fm = gid * WGM, gsz = (nM - fm) < WGM ? (nM - fm) : WGM;
        u.pm = fm + ((wgid % nig) % gsz); u.pn = (wgid % nig) / gsz; return true;
    }
};

template <class Epi>
__device__ __forceinline__ void gemm_phase(LAS unsigned char* lds, const Gemm g, const StaticOrder& S, const Epi& E) {
    const int tid = tidx(), wid = __builtin_amdgcn_readfirstlane(tid >> 6), lane = tid & 63, wr = wid >> 2, wc = wid & 3, fr = lane & 15, fq = lane >> 4;
    const int K = g.K, nt = K / BK;
    unsigned voffA[2], voffB[2];
#pragma unroll
    for (int i = 0; i < 2; ++i) { int R, C; stage_rc(tid * 16 + i * 8192, R, C); const int Rb = (R & ~31) + perm32(R & 31);
        voffA[i] = (unsigned)(R * K + C) * 2u; voffB[i] = (unsigned)(Rb * K + C) * 2u; }
    const size_t kstep = (size_t)(BK * 2);
    const size_t hstep = (size_t)HALF * K * 2;
    const size_t tstep = 2 * hstep;
    const unsigned ldsw = (unsigned)wid * 1024u;
    const int aoff = lds_byte(wr * 64 + fr, fq * 8), boff = lds_byte(wc * 32 + fr, fq * 8);
#define PG8_SA(b, h) (((b) * 2 + (h)) * HTB)
#define PG8_SB(b, h) ((4 + (b) * 2 + (h)) * HTB)
#define PG8_STAGE(bufoff, gbase, voff) do { _Pragma("unroll") for (int _i = 0; _i < 2; ++_i) \
        __builtin_amdgcn_global_load_lds((const unsigned*)((const char*)(gbase) + (voff)[_i]), (LAS unsigned*)(lds + (bufoff) + ldsw + _i * 8192), 16, 0, 0); } while (0)
#define PG8_LDA(dst, b, h) do { _Pragma("unroll") for (int m = 0; m < 4; ++m) _Pragma("unroll") for (int k = 0; k < 2; ++k) dst[m][k] = *(const LAS bf16x8*)(lds + PG8_SA(b, h) + aoff + m * 2048 + k * 1024); } while (0)
#define PG8_LDB(dst, b, h) do { _Pragma("unroll") for (int n = 0; n < 2; ++n) _Pragma("unroll") for (int k = 0; k < 2; ++k) dst[n][k] = *(const LAS bf16x8*)(lds + PG8_SB(b, h) + boff + n * 2048 + k * 1024); } while (0)
#define PG8_MMA(ai, bj, At, Bt) do { __builtin_amdgcn_s_setprio(1); _Pragma("unroll") for (int m = 0; m < 4; ++m) _Pragma("unroll") for (int n = 0; n < 2; ++n) _Pragma("unroll") for (int k = 0; k < 2; ++k) \
        acc[ai][bj][m][n] = __builtin_amdgcn_mfma_f32_16x16x32_bf16(Bt[n][k], At[m][k], acc[ai][bj][m][n], 0, 0, 0); __builtin_amdgcn_s_setprio(0); } while (0)
#define PG8_WAIT_V(n) asm volatile("s_waitcnt vmcnt(" #n ")" ::: "memory")
#define PG8_WAIT_L(n) asm volatile("s_waitcnt lgkmcnt(" #n ")" ::: "memory")
#define PG8_BAR __builtin_amdgcn_s_barrier()
#define PG8_SCHED __builtin_amdgcn_sched_barrier(0)
    Unit cur, nxt; int ui = 0;
    if (!S.next(0, cur)) return;
    f32x4 acc[2][2][4][2];
#pragma unroll
    for (int a = 0; a < 2; ++a)
#pragma unroll
        for (int b = 0; b < 2; ++b)
#pragma unroll
            for (int m = 0; m < 4; ++m)
#pragma unroll
                for (int n = 0; n < 2; ++n) acc[a][b][m][n] = (f32x4){0.f, 0.f, 0.f, 0.f};
    bf16x8 At[4][2], B0[2][2], B1[2][2];
    const char* cA = selA(g, cur.sel) + (size_t)cur.pm * tstep; const char* cB = selB(g, cur.sel) + (size_t)cur.pn * tstep;
    PG8_STAGE(PG8_SB(0, 0), cB, voffB); PG8_STAGE(PG8_SA(0, 0), cA, voffA); PG8_STAGE(PG8_SB(0, 1), cB + hstep, voffB); PG8_STAGE(PG8_SA(0, 1), cA + hstep, voffA);
    if (wr == 1) PG8_BAR;
    PG8_WAIT_V(4); PG8_BAR;
    PG8_STAGE(PG8_SB(1, 0), cB + kstep, voffB); PG8_STAGE(PG8_SA(1, 0), cA + kstep, voffA); PG8_STAGE(PG8_SB(1, 1), cB + hstep + kstep, voffB);
    PG8_WAIT_V(6); PG8_BAR;
    for (;;) {
        const bool has_next = S.next(ui + 1, nxt);
        const char* nA = has_next ? selA(g, nxt.sel) + (size_t)nxt.pm * tstep : cA; const char* nB = has_next ? selB(g, nxt.sel) + (size_t)nxt.pn * tstep : cB;
        for (int t = 0; t < nt; t += 2) {
            const bool last = (t == nt - 2);
            const char* a1 = cA + (size_t)(t + 1) * kstep;
            const char* a2 = last ? nA : cA + (size_t)(t + 2) * kstep; const char* b2 = last ? nB : cB + (size_t)(t + 2) * kstep;
            const char* a3 = a2 + kstep; const char* b3 = b2 + kstep;
            PG8_LDB(B0, 0, 0); PG8_SCHED; PG8_LDA(At, 0, 0); PG8_STAGE(PG8_SA(1, 1), a1 + hstep, voffA);
            PG8_WAIT_L(8); PG8_BAR; PG8_WAIT_L(0); PG8_MMA(0, 0, At, B0); PG8_BAR; PG8_SCHED;
            PG8_LDB(B1, 0, 1); PG8_STAGE(PG8_SB(0, 0), b2, voffB);
            PG8_BAR; PG8_WAIT_L(0); PG8_MMA(0, 1, At, B1); PG8_BAR;
            PG8_LDA(At, 0, 1); PG8_STAGE(PG8_SA(0, 0), a2, voffA);
            PG8_BAR; PG8_WAIT_L(0); PG8_MMA(1, 0, At, B0); PG8_BAR; PG8_SCHED;
            PG8_STAGE(PG8_SB(0, 1), b2 + hstep, voffB);
            PG8_WAIT_V(6); PG8_BAR; PG8_MMA(1, 1, At, B1); PG8_BAR;
            PG8_LDB(B0, 1, 0); PG8_SCHED; PG8_LDA(At, 1, 0); PG8_STAGE(PG8_SA(0, 1), a2 + hstep, voffA);
            PG8_WAIT_L(8); PG8_BAR; PG8_WAIT_L(0); PG8_MMA(0, 0, At, B0); PG8_BAR; PG8_SCHED;
            PG8_LDB(B1, 1, 1); PG8_STAGE(PG8_SB(1, 0), b3, voffB);
            PG8_BAR; PG8_WAIT_L(0); PG8_MMA(0, 1, At, B1); PG8_BAR;
            PG8_LDA(At, 1, 1); PG8_STAGE(PG8_SA(1, 0), a3, voffA);
            PG8_BAR; PG8_WAIT_L(0); PG8_MMA(1, 0, At, B0); PG8_BAR; PG8_SCHED;
            PG8_STAGE(PG8_SB(1, 1), b3 + hstep, voffB);
            PG8_WAIT_V(6); PG8_BAR; PG8_MMA(1, 1, At, B1); PG8_BAR;
        }
        E(acc, cur, wr, wc, fr, fq);
        if (!has_next) break;
#pragma unroll
        for (int a = 0; a < 2; ++a)
#pragma unroll
            for (int b = 0; b < 2; ++b)
#pragma unroll
                for (int m = 0; m < 4; ++m)
#pragma unroll
                    for (int n = 0; n < 2; ++n) acc[a][b][m][n] = (f32x4){0.f, 0.f, 0.f, 0.f};
        cur = nxt; cA = nA; cB = nB; ++ui;
    }
    PG8_WAIT_V(0);
    if (wr == 0) PG8_BAR;
    PG8_BAR;
#undef PG8_SA
#undef PG8_SB
#undef PG8_STAGE
#undef PG8_LDA
#undef PG8_LDB
#undef PG8_MMA
#undef PG8_WAIT_V
#undef PG8_WAIT_L
#undef PG8_BAR
#undef PG8_SCHED
}
}

typedef f32x4 AccT[2][2][4][2];
__device__ __forceinline__ u32x4 pack8(const f32x4 a, const f32x4 b) { u32x4 w; w.x = cvt_pk_bf16(a[0], a[1]); w.y = cvt_pk_bf16(a[2], a[3]); w.z = cvt_pk_bf16(b[0], b[1]); w.w = cvt_pk_bf16(b[2], b[3]); return w; }
__device__ __forceinline__ void unpack8(const u32x4 w, f32x4& a, f32x4& b) { a = (f32x4){bflo(w.x), bfhi(w.x), bflo(w.y), bfhi(w.y)}; b = (f32x4){bflo(w.z), bfhi(w.z), bflo(w.w), bfhi(w.w)}; }

struct EpiIn {
    bf16_t* P; float* glr; const float* cosT; const float* sinT;
    __device__ __forceinline__ void operator()(const AccT& acc, const pg8::Unit& u, int wr, int wc, int fr, int fq) const {
        const int pn = u.pn; const int row0 = u.pm * 256 + wr * 64 + fr;
        int mode = 0; float scale = 1.0f;
        if (pn < 8) { mode = 1; scale = pn >= 4 ? 0.08838834764831845f : 1.0f; }
        else if ((pn >= 12 && pn < 16) || (pn >= 24 && pn < 28) || (pn >= 32 && pn < 36)) mode = 2;
        else if (pn >= 36 && pn < 60) mode = 3;
        else if (pn == 60) mode = 4;
        else if (pn == 16 || pn == 17) scale = 0.08838834764831845f;
        if (mode == 4) {
            if (wc == 0 && fq < 2) {
#pragma unroll
                for (int ai = 0; ai < 2; ++ai)
#pragma unroll
                    for (int m = 0; m < 4; ++m) { float* gp = glr + (size_t)(row0 + ai * 128 + m * 16) * 16 + 8 * fq;
                        *(f32x4*)gp = acc[ai][0][m][0]; *(f32x4*)(gp + 4) = acc[ai][0][m][1]; }
            }
            return;
        }
        const int i4 = 4 * (4 * wc + fq);
#pragma unroll
        for (int ai = 0; ai < 2; ++ai)
#pragma unroll
            for (int m = 0; m < 4; ++m) {
                const int r = row0 + ai * 128 + m * 16;
                bf16_t* rowp = P + (size_t)r * PLD + pn * 256 + wc * 32 + 8 * fq;
                f32x4 cs = (f32x4){1.f, 1.f, 1.f, 1.f}, sn = (f32x4){0.f, 0.f, 0.f, 0.f};
                if (mode == 1) { const int pos = r >= ROW0 ? r - ROW0 : 0; cs = *(const f32x4*)(cosT + (size_t)pos * 64 + i4); sn = *(const f32x4*)(sinT + (size_t)pos * 64 + i4); }
#pragma unroll
                for (int bj = 0; bj < 2; ++bj) {
                    f32x4 v0 = acc[ai][bj][m][0], v1 = acc[ai][bj][m][1];
                    if (mode == 1) { const f32x4 o1 = v0 * cs - v1 * sn, o2 = v0 * sn + v1 * cs; v0 = o1 * scale; v1 = o2 * scale; }
                    else if (mode == 2) {
#pragma unroll
                        for (int j = 0; j < 4; ++j) { v0[j] = siluf_(v0[j]); v1[j] = siluf_(v1[j]); } }
                    else if (mode == 3) {
#pragma unroll
                        for (int j = 0; j < 4; ++j) { v0[j] = sigmoidf_(v0[j]); v1[j] = sigmoidf_(v1[j]); } }
                    else { v0 = v0 * scale; v1 = v1 * scale; }
                    *(u32x4*)(rowp + bj * 128) = pack8(v0, v1);
                }
            }
    }
};
struct EpiGlu {
    const bf16_t* sopre; const bf16_t* P; bf16_t* so;
    __device__ __forceinline__ void operator()(const AccT& acc, const pg8::Unit& u, int wr, int wc, int fr, int fq) const {
        const int row0 = u.pm * 256 + wr * 64 + fr, col0 = u.pn * 256 + wc * 32 + 8 * fq;
#pragma unroll
        for (int ai = 0; ai < 2; ++ai)
#pragma unroll
            for (int m = 0; m < 4; ++m) { const int r = row0 + ai * 128 + m * 16;
#pragma unroll
                for (int bj = 0; bj < 2; ++bj) { const int c = col0 + bj * 128;
                    const u32x4 sp = *(const u32x4*)(sopre + (size_t)r * 1024 + c), gt = *(const u32x4*)(P + (size_t)r * PLD + C_SG + c);
                    f32x4 s0, s1, g0, g1; unpack8(sp, s0, s1); unpack8(gt, g0, g1);
                    f32x4 v0 = acc[ai][bj][m][0], v1 = acc[ai][bj][m][1];
#pragma unroll
                    for (int j = 0; j < 4; ++j) { v0[j] = s0[j] * sigmoidf_(v0[j]) * g0[j]; v1[j] = s1[j] * sigmoidf_(v1[j]) * g1[j]; }
                    *(u32x4*)(so + (size_t)r * 1024 + c) = pack8(v0, v1); } }
    }
};
struct EpiBr {
    const bf16_t* P; float* yacc; bf16_t* y;
    __device__ __forceinline__ void operator()(const AccT& acc, const pg8::Unit& u, int wr, int wc, int fr, int fq) const {
        const int row0 = u.pm * 256 + wr * 64 + fr, col0 = u.pn * 256 + wc * 32 + 8 * fq; const int sel = u.sel;
#pragma unroll
        for (int ai = 0; ai < 2; ++ai)
#pragma unroll
            for (int m = 0; m < 4; ++m) { const int r = row0 + ai * 128 + m * 16;
#pragma unroll
                for (int bj = 0; bj < 2; ++bj) { const int c = col0 + bj * 128;
                    const u32x4 gt = *(const u32x4*)(P + (size_t)r * PLD + C_MG + sel * 2048 + c);
                    f32x4 g0, g1; unpack8(gt, g0, g1);
                    f32x4 v0 = acc[ai][bj][m][0] * g0, v1 = acc[ai][bj][m][1] * g1;
                    float* yp = yacc + (size_t)r * DM + c;
                    if (sel > 0) { v0 = v0 + *(const f32x4*)yp; v1 = v1 + *(const f32x4*)(yp + 4); }
                    if (sel < 2) { *(f32x4*)yp = v0; *(f32x4*)(yp + 4) = v1; }
                    else *(u32x4*)(y + (size_t)r * DM + c) = pack8(v0, v1); } }
    }
};
struct EpiOut {
    float* H;
    __device__ __forceinline__ void operator()(const AccT& acc, const pg8::Unit& u, int wr, int wc, int fr, int fq) const {
        const int row0 = u.pm * 256 + wr * 64 + fr, col0 = u.pn * 256 + wc * 32 + 8 * fq;
#pragma unroll
        for (int ai = 0; ai < 2; ++ai)
#pragma unroll
            for (int m = 0; m < 4; ++m) { const int r = row0 + ai * 128 + m * 16;
#pragma unroll
                for (int bj = 0; bj < 2; ++bj) { float* hp = H + (size_t)r * DM + col0 + bj * 128;
                    const f32x4 a = *(const f32x4*)hp, b = *(const f32x4*)(hp + 4);
                    *(f32x4*)hp = a + acc[ai][bj][m][0]; *(f32x4*)(hp + 4) = b + acc[ai][bj][m][1]; } }
    }
};

__device__ __forceinline__ int win_dst_row(int c) {
    if (c < 2048) { const int hd = c >> 7, d = c & 127, i = d & 63, half = d >> 6; return (hd << 7) + 8 * (i >> 2) + 4 * half + (i & 3); }
    if (c < 7168) return c;
    if (c < 7184) return 15360 + (c - 7168);
    return c - 16;
}
__device__ __forceinline__ void cvt_tile(LAS unsigned char* lds, const float* src, int K, int Ns, bf16_t* dst, int k0, int n0, bool winmap) {
    const int t = tidx(); LAS bf16_t* T = (LAS bf16_t*)lds;
    { const int kk = t >> 5, n4 = (t & 31) * 4;
        f32x4 v[4];
#pragma unroll
        for (int i = 0; i < 4; ++i) { const int k = kk + 16 * i; v[i] = (n0 + n4 < Ns) ? *(const f32x4*)(src + (size_t)(k0 + k) * Ns + n0 + n4) : (f32x4){0.f, 0.f, 0.f, 0.f}; }
#pragma unroll
        for (int i = 0; i < 4; ++i) { const int k = kk + 16 * i;
#pragma unroll
            for (int j = 0; j < 4; ++j) T[(n4 + j) * 72 + k] = f2bf(v[i][j]); } }
    __syncthreads();
    { const int n = t >> 2, seg = t & 3;
        if (n0 + n < Ns) { const int dr = winmap ? win_dst_row(n0 + n) : (n0 + n);
            const u32x4 a = *(const LAS u32x4*)(lds + n * 144 + seg * 32), b = *(const LAS u32x4*)(lds + n * 144 + seg * 32 + 16);
            bf16_t* dp = dst + (size_t)dr * K + k0 + seg * 16; *(u32x4*)dp = a; *(u32x4*)(dp + 8) = b; } }
    __syncthreads();
}
__device__ __forceinline__ void phase_prep(const Params& p, unsigned char* ws, LAS unsigned char* lds, int bid, int nb) {
    const int t = tidx();
    constexpr int T_IN = 32 * 121, T_GLU = 16 * 8, T_BR = 16 * 16, T_OUT = 32 * 16, T_L = T_IN + T_GLU + 3 * T_BR + T_OUT;
    for (int tile = bid; tile < DEPTH * T_L; tile += nb) {
        const int l = tile / T_L; int r = tile - l * T_L;
        if (r < T_IN) { cvt_tile(lds, p.w_in + (size_t)l * DM * NIN_SRC, DM, NIN_SRC, (bf16_t*)(ws + WS_WIN) + (size_t)l * NIN_T * DM, (r / 121) * 64, (r % 121) * 128, true); continue; }
        r -= T_IN;
        if (r < T_GLU) { cvt_tile(lds, p.s5_wglu + (size_t)l * 1024 * 1024, 1024, 1024, (bf16_t*)(ws + WS_WGLU) + (size_t)l * 1024 * 1024, (r / 8) * 64, (r % 8) * 128, false); continue; }
        r -= T_GLU;
        if (r < 3 * T_BR) { const int b = r / T_BR; r -= b * T_BR; const float* src = (b == 0 ? p.w_br_ret : (b == 1 ? p.w_br_gla : p.w_br_s5)) + (size_t)l * 1024 * 2048;
            cvt_tile(lds, src, 1024, 2048, (bf16_t*)(ws + WS_WBR) + (size_t)(l * 3 + b) * 2048 * 1024, (r / 16) * 64, (r % 16) * 128, false); continue; }
        r -= 3 * T_BR;
        cvt_tile(lds, p.w_out + (size_t)l * 2048 * 2048, 2048, 2048, (bf16_t*)(ws + WS_WOUT) + (size_t)l * 2048 * 2048, (r / 16) * 64, (r % 16) * 128, false);
    }
    const size_t gtid = (size_t)bid * NT + t, gsz = (size_t)nb * NT;
    for (size_t i = gtid; i < (size_t)DEPTH * 240 * DM / 8; i += gsz) { const size_t l = i / (240 * DM / 8), o = i % (240 * DM / 8);
        *(u32x4*)((bf16_t*)(ws + WS_WIN) + (l * NIN_T + 15376) * DM + o * 8) = (u32x4){0u, 0u, 0u, 0u}; }
    float* H = (float*)(ws + WS_H);
    for (size_t i = gtid; i < (size_t)MR * DM / 4; i += gsz) { const int r = (int)(i / (DM / 4)), c4 = (int)(i % (DM / 4)) * 4;
        f32x4 v = (f32x4){0.f, 0.f, 0.f, 0.f};
        if (r >= 256) v = *(const f32x4*)(p.x + (size_t)(r - 256) * DM + c4); else if (r >= ROW0) v = *(const f32x4*)(p.meta + (size_t)(r - ROW0) * DM + c4);
        *(f32x4*)(H + (size_t)r * DM + c4) = v; }
    float* cosT = (float*)(ws + WS_COS); float* sinT = (float*)(ws + WS_SIN);
    for (size_t i = gtid; i < (size_t)MR * 64; i += gsz) { const int pos = (int)(i >> 6), k = (int)(i & 63);
        const float inv = exp2f(-(float)k * (13.287712379549449f / 64.0f)); const float ang = (float)pos * inv; float s, c; sincos_red(ang, s, c); cosT[i] = c; sinT[i] = s; }
    for (size_t i = gtid; i < (size_t)128 * 1024 / 8; i += gsz) { const u32x4 z = (u32x4){0u, 0u, 0u, 0u};
        *(u32x4*)((bf16_t*)(ws + WS_RO) + i * 8) = z; *(u32x4*)((bf16_t*)(ws + WS_GO) + i * 8) = z; *(u32x4*)((bf16_t*)(ws + WS_SOPRE) + i * 8) = z; }
}

__device__ __forceinline__ void phase_rmsnorm(const float* H, const float* g, bf16_t* HN, int bid, int nb) {
    const int wave = tidx() >> 6, lane = tidx() & 63;
    for (int r = bid * 8 + wave; r < MR; r += nb * 8) {
        const float* hp = H + (size_t)r * DM; f32x4 v[8]; float ss = 0.f;
#pragma unroll
        for (int j = 0; j < 8; ++j) { v[j] = *(const f32x4*)(hp + (j * 64 + lane) * 4); ss += v[j][0] * v[j][0] + v[j][1] * v[j][1] + v[j][2] * v[j][2] + v[j][3] * v[j][3]; }
#pragma unroll
        for (int o = 32; o >= 1; o >>= 1) ss += __shfl_xor(ss, o);
        const float rs = rsqrtf(ss * (1.0f / DM) + EPS);
#pragma unroll
        for (int j = 0; j < 8; ++j) { const int c = (j * 64 + lane) * 4; const f32x4 gv = *(const f32x4*)(g + c); const f32x4 o = v[j] * rs * gv;
            u32x2 w; w.x = cvt_pk_bf16(o[0], o[1]); w.y = cvt_pk_bf16(o[2], o[3]); *(u32x2*)(HN + (size_t)r * DM + c) = w; }
    }
}
__device__ __forceinline__ void phase_final(const float* H, const float* g, float* out, int bid, int nb) {
    const int wave = tidx() >> 6, lane = tidx() & 63;
    for (int r = bid * 8 + wave; r < SEQ; r += nb * 8) {
        const float* hp = H + (size_t)(r + 256) * DM; f32x4 v[8]; float ss = 0.f;
#pragma unroll
        for (int j = 0; j < 8; ++j) { v[j] = *(const f32x4*)(hp + (j * 64 + lane) * 4); ss += v[j][0] * v[j][0] + v[j][1] * v[j][1] + v[j][2] * v[j][2] + v[j][3] * v[j][3]; }
#pragma unroll
        for (int o = 32; o >= 1; o >>= 1) ss += __shfl_xor(ss, o);
        const float rs = rsqrtf(ss * (1.0f / DM) + EPS);
#pragma unroll
        for (int j = 0; j < 8; ++j) { const int c = (j * 64 + lane) * 4; const f32x4 gv = *(const f32x4*)(g + c); *(f32x4*)(out + (size_t)r * DM + c) = v[j] * rs * gv; }
    }
}

constexpr int P128 = 272;
constexpr int P256 = 528;
__device__ __forceinline__ void stage_tile(LAS unsigned char* img, int lp, const bf16_t* g, size_t gp, int ncols) {
    const int segs = ncols >> 3, total = 128 * segs;
    for (int i = tidx(); i < total; i += NT) { const int r = i / segs, s = i - r * segs;
        *(LAS u32x4*)(img + r * lp + s * 16) = *(const u32x4*)(g + (size_t)r * gp + s * 8); }
}
__device__ __forceinline__ void stage_tile_kdec(LAS unsigned char* img, int lp, const bf16_t* g, size_t gp, float lg) {
    for (int i = tidx(); i < 128 * 16; i += NT) { const int r = i >> 4, s = i & 15; const float sc = __expf(lg * (float)(127 - r));
        const u32x4 w = *(const u32x4*)(g + (size_t)r * gp + s * 8); f32x4 a, b; unpack8(w, a, b); *(LAS u32x4*)(img + r * lp + s * 16) = pack8(a * sc, b * sc); }
}

__device__ __forceinline__ void gla_gate(const Params& p, unsigned char* ws, int l, int n, int h, LAS float* glrS  , LAS float* segT  , float (&bl)[32], float& blast) {
    const int t = tidx(), d = t & 127, seg = t >> 7;
    const float* GLR = (const float*)(ws + WS_GLR);
    for (int i = t; i < 128 * 16 / 4; i += NT) *(LAS f32x4*)(glrS + i * 4) = *(const f32x4*)(GLR + (size_t)n * 128 * 16 + i * 4);
    float wa[16];
#pragma unroll
    for (int r = 0; r < 16; ++r) wa[r] = p.gla_w_a[((size_t)l * 16 + r) * 512 + h * 128 + d];
    const float ba = p.gla_b_a[(size_t)l * 512 + h * 128 + d];
    __syncthreads();
    float cum = 0.f;
#pragma unroll
    for (int i = 0; i < 32; ++i) { const int s = seg * 32 + i; float x = ba;
#pragma unroll
        for (int r4 = 0; r4 < 4; ++r4) { const f32x4 gv = *(const LAS f32x4*)(glrS + s * 16 + r4 * 4); x += gv[0] * wa[r4 * 4] + gv[1] * wa[r4 * 4 + 1] + gv[2] * wa[r4 * 4 + 2] + gv[3] * wa[r4 * 4 + 3]; }
        float la = logsigmoidf_(x) * (1.0f / 16.0f); if (n * 128 + s < ROW0) la = 0.f;
        cum += la; bl[i] = cum; }
    segT[seg * 128 + d] = cum;
    __syncthreads();
    float pre = 0.f, tot = 0.f;
#pragma unroll
    for (int k = 0; k < 4; ++k) { const float v = segT[k * 128 + d]; tot += v; if (k < seg) pre += v; }
#pragma unroll
    for (int i = 0; i < 32; ++i) bl[i] += pre;
    blast = tot;
}

__device__ __forceinline__ void ret_state_unit(const Params& p, unsigned char* ws, LAS unsigned char* lds, int n, int h) {
    const int t = tidx(), w = t >> 6, lane = t & 63;
    const bf16_t* PJ = (const bf16_t*)(ws + WS_PROJ) + (size_t)n * 128 * PLD;
    LAS unsigned char* Kimg = lds; LAS unsigned char* Vimg = lds + 128 * P128;
    const float lg = ret_log_gamma(h);
    stage_tile_kdec(Kimg, P128, PJ + C_RK + h * 128, PLD, lg);
    stage_tile(Vimg, P128, PJ + C_RV + h * 128, PLD, 128);
    __syncthreads();
    const int d0 = (w >> 1) * 32, v0 = (w & 1) * 64;
    f32x4 acc[2][4];
#pragma unroll
    for (int a = 0; a < 2; ++a)
#pragma unroll
        for (int b = 0; b < 4; ++b) acc[a][b] = (f32x4){0.f, 0.f, 0.f, 0.f};
#pragma unroll
    for (int ks = 0; ks < 4; ++ks) { bf16x8 a[2], b[4];
#pragma unroll
        for (int mi = 0; mi < 2; ++mi) a[mi] = frag_tr(Kimg, P128, 32 * ks, d0 + 16 * mi, lane);
#pragma unroll
        for (int ni = 0; ni < 4; ++ni) b[ni] = frag_tr(Vimg, P128, 32 * ks, v0 + 16 * ni, lane);
#pragma unroll
        for (int mi = 0; mi < 2; ++mi)
#pragma unroll
            for (int ni = 0; ni < 4; ++ni) acc[mi][ni] = MFMA16(a[mi], b[ni], acc[mi][ni]); }
    float* KV = (float*)(ws + WS_RKV) + (size_t)(n * 8 + h) * 128 * 128;
#pragma unroll
    for (int mi = 0; mi < 2; ++mi)
#pragma unroll
        for (int ni = 0; ni < 4; ++ni)
#pragma unroll
            for (int r = 0; r < 4; ++r) KV[(d0 + 16 * mi + 4 * (lane >> 4) + r) * 128 + v0 + 16 * ni + (lane & 15)] = acc[mi][ni][r];
    __syncthreads();
}
__device__ __forceinline__ void gla_state_unit(const Params& p, unsigned char* ws, LAS unsigned char* lds, int l, int n, int h) {
    const int t = tidx(), w = t >> 6, lane = t & 63, d = t & 127, seg = t >> 7;
    const bf16_t* PJ = (const bf16_t*)(ws + WS_PROJ) + (size_t)n * 128 * PLD;
    LAS unsigned char* Kimg = lds; LAS unsigned char* Vimg = lds + 128 * P128;
    LAS float* glrS = (LAS float*)(lds + 128 * P128 + 128 * P256); LAS float* segT = glrS + 128 * 16;
    float bl[32], blast;
    gla_gate(p, ws, l, n, h, glrS, segT, bl, blast);
#pragma unroll
    for (int i = 0; i < 32; ++i) { const int s = seg * 32 + i; const float k = bf2f(PJ[(size_t)s * PLD + C_GK + h * 128 + d]);
        *(LAS bf16_t*)(Kimg + s * P128 + d * 2) = f2bf(k * __expf(blast - bl[i])); }
    if (seg == 0) ((float*)(ws + WS_GDEC))[(size_t)(n * 4 + h) * 128 + d] = __expf(blast);
    stage_tile(Vimg, P256, PJ + C_GV + h * 256, PLD, 256);
    __syncthreads();
    const int d0 = (w >> 2) * 64, v0 = (w & 3) * 64;
    f32x4 acc[4][4];
#pragma unroll
    for (int a = 0; a < 4; ++a)
#pragma unroll
        for (int b = 0; b < 4; ++b) acc[a][b] = (f32x4){0.f, 0.f, 0.f, 0.f};
#pragma unroll
    for (int ks = 0; ks < 4; ++ks) { bf16x8 a[4], b[4];
#pragma unroll
        for (int mi = 0; mi < 4; ++mi) a[mi] = frag_tr(Kimg, P128, 32 * ks, d0 + 16 * mi, lane);
#pragma unroll
        for (int ni = 0; ni < 4; ++ni) b[ni] = frag_tr(Vimg, P256, 32 * ks, v0 + 16 * ni, lane);
#pragma unroll
        for (int mi = 0; mi < 4; ++mi)
#pragma unroll
            for (int ni = 0; ni < 4; ++ni) acc[mi][ni] = MFMA16(a[mi], b[ni], acc[mi][ni]); }
    float* KV = (float*)(ws + WS_GKV) + (size_t)(n * 4 + h) * 128 * 256;
#pragma unroll
    for (int mi = 0; mi < 4; ++mi)
#pragma unroll
        for (int ni = 0; ni < 4; ++ni)
#pragma unroll
            for (int r = 0; r < 4; ++r) KV[(d0 + 16 * mi + 4 * (lane >> 4) + r) * 256 + v0 + 16 * ni + (lane & 15)] = acc[mi][ni][r];
    __syncthreads();
}

__device__ __forceinline__ void s5_disc(const Params& p, int l, int g, int pp, float& ar, float& ai, float& fre, float& fim) {
    const float dt = __expf(p.s5_logdt[l * 64 + g]); const float lr = p.s5_lre[(size_t)(l * 64 + g) * 64 + pp], li = p.s5_lim[(size_t)(l * 64 + g) * 64 + pp];
    const float mag = __expf(lr * dt); float s, c; sincos_red(li * dt, s, c); ar = mag * c; ai = mag * s;
    const float den = lr * lr + li * li, nr = ar - 1.0f, ni = ai; fre = (nr * lr + ni * li) / den; fim = (ni * lr - nr * li) / den;
}
constexpr int S5_BU = 0;
constexpr int S5_U = S5_BU + 128 * 132 * 4;
constexpr int S5_BB = S5_U + 128 * 80;
constexpr int S5_H = S5_BB + 128 * 80;
constexpr int S5_C = S5_H + 128 * P128;
constexpr int S5_SEG = S5_C + 16 * P128;
__device__ __forceinline__ void s5_unit(const Params& p, unsigned char* ws, LAS unsigned char* lds, int l, int n, int g, int mode) {
    const int t = tidx(), w = t >> 6, lane = t & 63;
    const bf16_t* PJ = (const bf16_t*)(ws + WS_PROJ) + (size_t)n * 128 * PLD;
    LAS float* BU = (LAS float*)(lds + S5_BU); LAS unsigned char* Uimg = lds + S5_U; LAS unsigned char* BBimg = lds + S5_BB;
    LAS unsigned char* Himg = lds + S5_H; LAS unsigned char* Cimg = lds + S5_C; LAS float* SEG = (LAS float*)(lds + S5_SEG);
    { const int pp = t >> 3, c2 = (t & 7) * 2; float ar, ai, fre, fim; s5_disc(p, l, g, pp, ar, ai, fre, fim);
        const size_t bo = ((size_t)(l * 64 + g) * 64 + pp) * 16 + c2;
        const float br0 = p.s5_bre[bo], br1 = p.s5_bre[bo + 1], bi0 = p.s5_bim[bo], bi1 = p.s5_bim[bo + 1];
        *(LAS unsigned*)(BBimg + pp * 80 + c2 * 2) = cvt_pk_bf16(fre * br0 - fim * bi0, fre * br1 - fim * bi1);
        *(LAS unsigned*)(BBimg + (64 + pp) * 80 + c2 * 2) = cvt_pk_bf16(fre * bi0 + fim * br0, fre * bi1 + fim * br1); }
    if (t < 256) { const int r = t >> 1, hf = t & 1;
        *(LAS u32x4*)(Uimg + r * 80 + hf * 16) = *(const u32x4*)(PJ + (size_t)r * PLD + C_SU + g * 16 + hf * 8);
        *(LAS u32x4*)(BBimg + r * 80 + 32 + hf * 16) = (u32x4){0u, 0u, 0u, 0u}; }
    else { const int r = (t - 256) >> 1, hf = t & 1; *(LAS u32x4*)(Uimg + r * 80 + 32 + hf * 16) = (u32x4){0u, 0u, 0u, 0u}; }
    if (mode == 1) {
        for (int i = t; i < 16 * 128; i += NT) { const int c = i >> 7, k = i & 127; const size_t co = ((size_t)(l * 64 + g) * 16 + c) * 64 + (k & 63);
            *(LAS bf16_t*)(Cimg + c * P128 + k * 2) = f2bf(k < 64 ? p.s5_cre[co] : -p.s5_cim[co]); } }
    __syncthreads();
    { const bf16x8 a = frag_row(Uimg, 80, 16 * w, 0, lane);
#pragma unroll
        for (int ni = 0; ni < 8; ++ni) { const bf16x8 b = frag_row(BBimg, 80, 16 * ni, 0, lane); f32x4 acc = (f32x4){0.f, 0.f, 0.f, 0.f}; acc = MFMA16(a, b, acc);
#pragma unroll
            for (int r = 0; r < 4; ++r) BU[(16 * w + 4 * (lane >> 4) + r) * 132 + 16 * ni + (lane & 15)] = acc[r]; } }
    __syncthreads();
    float ar, ai, fre, fim; s5_disc(p, l, g, lane, ar, ai, fre, fim);
    float hlr[16], hli[16];
    { float hr = 0.f, hi = 0.f;
#pragma unroll
        for (int i = 0; i < 16; ++i) { const float bur = BU[(16 * w + i) * 132 + lane], bui = BU[(16 * w + i) * 132 + 64 + lane];
            const float nr = ar * hr - ai * hi + bur, ni = ar * hi + ai * hr + bui; hr = nr; hi = ni; hlr[i] = hr; hli[i] = hi; }
        SEG[(w * 64 + lane) * 2] = hr; SEG[(w * 64 + lane) * 2 + 1] = hi; }
    __syncthreads();
    float a16r = ar, a16i = ai;
#pragma unroll
    for (int k = 0; k < 4; ++k) { const float nr = a16r * a16r - a16i * a16i, ni = 2.0f * a16r * a16i; a16r = nr; a16i = ni; }
    float hinr = 0.f, hini = 0.f;
    if (mode == 1) { const float* Hs = (const float*)(ws + WS_S5H) + ((size_t)(n * 64 + g) * 64 + lane) * 2; hinr = Hs[0]; hini = Hs[1]; }
    for (int k = 0; k < w; ++k) { const float sr = SEG[(k * 64 + lane) * 2], si = SEG[(k * 64 + lane) * 2 + 1];
        const float nr = a16r * hinr - a16i * hini + sr, ni = a16r * hini + a16i * hinr + si; hinr = nr; hini = ni; }
    { float pr = ar, pi = ai;
#pragma unroll
        for (int i = 0; i < 16; ++i) { const float fr_ = hlr[i] + pr * hinr - pi * hini, fi_ = hli[i] + pr * hini + pi * hinr;
            if (mode == 1) { *(LAS bf16_t*)(Himg + (16 * w + i) * P128 + lane * 2) = f2bf(fr_); *(LAS bf16_t*)(Himg + (16 * w + i) * P128 + (64 + lane) * 2) = f2bf(fi_); }
            else if (i == 15 && w == 7) { float* E = (float*)(ws + WS_S5E) + ((size_t)(n * 64 + g) * 64 + lane) * 2; E[0] = fr_; E[1] = fi_; }
            const float nr = pr * ar - pi * ai, ni = pr * ai + pi * ar; pr = nr; pi = ni; } }
    __syncthreads();
    if (mode == 1) {
        f32x4 acc = (f32x4){0.f, 0.f, 0.f, 0.f};
#pragma unroll
        for (int ks = 0; ks < 4; ++ks) { const bf16x8 a = frag_row(Himg, P128, 16 * w, 32 * ks, lane), b = frag_row(Cimg, P128, 0, 32 * ks, lane); acc = MFMA16(a, b, acc); }
        const int c = lane & 15; const float dd = p.s5_d[(size_t)l * 1024 + g * 16 + c];
        bf16_t* SP = (bf16_t*)(ws + WS_SOPRE);
#pragma unroll
        for (int r = 0; r < 4; ++r) { const int tt = 16 * w + 4 * (lane >> 4) + r; const float u = bf2f(*(const LAS bf16_t*)(Uimg + tt * 80 + c * 2));
            SP[(size_t)(n * 128 + tt) * 1024 + g * 16 + c] = f2bf(geluf_(acc[r] + dd * u)); }
        __syncthreads();
    }
}

__device__ __forceinline__ void phase_scan(const Params& p, unsigned char* ws, int l, int bid, int nb) {
    const size_t gtid = (size_t)bid * NT + tidx(), gsz = (size_t)nb * NT;
    { const float* KV = (const float*)(ws + WS_RKV); bf16_t* PV = (bf16_t*)(ws + WS_RPREV);
        for (size_t e = gtid; e < (size_t)8 * 16384; e += gsz) { const int h = (int)(e >> 14); const size_t dv = e & 16383; const float g128 = __expf(ret_log_gamma(h) * 128.0f); float prev = 0.f;
#pragma unroll 5
            for (int n = 1; n < NCH; ++n) { const size_t idx = (size_t)(n * 8 + h) * 16384 + dv; const float kv = KV[idx]; PV[idx] = f2bf(prev); prev = g128 * prev + kv; } } }
    { const float* KV = (const float*)(ws + WS_GKV); bf16_t* PV = (bf16_t*)(ws + WS_GPREV); const float* DEC = (const float*)(ws + WS_GDEC);
        for (size_t e = gtid; e < (size_t)4 * 32768; e += gsz) { const int h = (int)(e >> 15); const size_t dv = e & 32767; const int d = (int)(dv >> 8); float prev = 0.f;
#pragma unroll 5
            for (int n = 1; n < NCH; ++n) { const size_t idx = (size_t)(n * 4 + h) * 32768 + dv; const float kv = KV[idx]; const float dc = DEC[(size_t)(n * 4 + h) * 128 + d]; PV[idx] = f2bf(prev); prev = dc * prev + kv; } } }
    { const float* E = (const float*)(ws + WS_S5E); float* Hs = (float*)(ws + WS_S5H);
        for (size_t e = gtid; e < (size_t)4096; e += gsz) { const int g = (int)(e >> 6), pp = (int)(e & 63); float ar, ai, fre, fim; s5_disc(p, l, g, pp, ar, ai, fre, fim);
#pragma unroll
            for (int k = 0; k < 7; ++k) { const float nr = ar * ar - ai * ai, ni = 2.0f * ar * ai; ar = nr; ai = ni; }
            float hr = 0.f, hi = 0.f;
#pragma unroll 5
            for (int n = 1; n < NCH; ++n) { const size_t idx = ((size_t)n * 4096 + e) * 2; const float er = E[idx], ei = E[idx + 1]; Hs[idx] = hr; Hs[idx + 1] = hi;
                const float nr = ar * hr - ai * hi + er, ni = ar * hi + ai * hr + ei; hr = nr; hi = ni; } } }
}

constexpr int OFF_Q = 0, OFF_KS = 128 * P128, OFF_V = 2 * 128 * P128, OFF_P = 3 * 128 * P128, OFF_X = 4 * 128 * P128;
__device__ __forceinline__ void ret_out_unit(const Params& p, unsigned char* ws, LAS unsigned char* lds, int l, int n, int h) {
    const int t = tidx(), w = t >> 6, lane = t & 63, g4 = lane >> 4, l15 = lane & 15;
    const bf16_t* PJ = (const bf16_t*)(ws + WS_PROJ) + (size_t)n * 128 * PLD;
    LAS unsigned char* Qimg = lds + OFF_Q; LAS unsigned char* KSimg = lds + OFF_KS; LAS unsigned char* Vimg = lds + OFF_V; LAS unsigned char* Pimg = lds + OFF_P;
    LAS float* RED = (LAS float*)(lds + OFF_X);
    const float lg = ret_log_gamma(h);
    stage_tile(Qimg, P128, PJ + C_RQ + h * 128, PLD, 128);
    stage_tile(KSimg, P128, PJ + C_RK + h * 128, PLD, 128);
    stage_tile(Vimg, P128, PJ + C_RV + h * 128, PLD, 128);
    stage_tile(Pimg, P128, (const bf16_t*)(ws + WS_RPREV) + (size_t)(n * 8 + h) * 16384, 128, 128);
    __syncthreads();
    const int c0 = (w >> 1) * 32, x0 = (w & 1) * 64;
    f32x4 sc[2][4];
#pragma unroll
    for (int a = 0; a < 2; ++a)
#pragma unroll
        for (int b = 0; b < 4; ++b) sc[a][b] = (f32x4){0.f, 0.f, 0.f, 0.f};
    if (x0 <= c0 + 31) {
#pragma unroll
        for (int ks = 0; ks < 4; ++ks) { bf16x8 a[2], b[4];
#pragma unroll
            for (int mi = 0; mi < 2; ++mi) a[mi] = frag_row(Qimg, P128, c0 + 16 * mi, 32 * ks, lane);
#pragma unroll
            for (int ni = 0; ni < 4; ++ni) b[ni] = frag_row(KSimg, P128, x0 + 16 * ni, 32 * ks, lane);
#pragma unroll
            for (int mi = 0; mi < 2; ++mi)
#pragma unroll
                for (int ni = 0; ni < 4; ++ni) sc[mi][ni] = MFMA16(a[mi], b[ni], sc[mi][ni]); } }
    __syncthreads();
#pragma unroll
    for (int mi = 0; mi < 2; ++mi)
#pragma unroll
        for (int ni = 0; ni < 4; ++ni)
#pragma unroll
            for (int r = 0; r < 4; ++r) { const int c = c0 + 16 * mi + 4 * g4 + r, s = x0 + 16 * ni + l15;
                const float v = (c >= s) ? sc[mi][ni][r] * __expf(lg * (float)(c - s)) : 0.f; *(LAS bf16_t*)(KSimg + c * P128 + s * 2) = f2bf(v); }
    __syncthreads();
    f32x4 a1[2][4], a2[2][4];
#pragma unroll
    for (int a = 0; a < 2; ++a)
#pragma unroll
        for (int b = 0; b < 4; ++b) { a1[a][b] = (f32x4){0.f, 0.f, 0.f, 0.f}; a2[a][b] = (f32x4){0.f, 0.f, 0.f, 0.f}; }
#pragma unroll
    for (int ks = 0; ks < 4; ++ks) { bf16x8 sa[2], qa[2], vb[4], pb[4];
#pragma unroll
        for (int mi = 0; mi < 2; ++mi) { sa[mi] = frag_row(KSimg, P128, c0 + 16 * mi, 32 * ks, lane); qa[mi] = frag_row(Qimg, P128, c0 + 16 * mi, 32 * ks, lane); }
#pragma unroll
        for (int ni = 0; ni < 4; ++ni) { vb[ni] = frag_tr(Vimg, P128, 32 * ks, x0 + 16 * ni, lane); pb[ni] = frag_tr(Pimg, P128, 32 * ks, x0 + 16 * ni, lane); }
#pragma unroll
        for (int mi = 0; mi < 2; ++mi)
#pragma unroll
            for (int ni = 0; ni < 4; ++ni) { a1[mi][ni] = MFMA16(sa[mi], vb[ni], a1[mi][ni]); a2[mi][ni] = MFMA16(qa[mi], pb[ni], a2[mi][ni]); } }
#pragma unroll
    for (int mi = 0; mi < 2; ++mi)
#pragma unroll
        for (int r = 0; r < 4; ++r) { const int c = c0 + 16 * mi + 4 * g4 + r; const float qd = __expf(lg * (float)(c + 1)); float s = 0.f, ss = 0.f;
#pragma unroll
            for (int ni = 0; ni < 4; ++ni) { const float o = a1[mi][ni][r] + qd * a2[mi][ni][r]; a1[mi][ni][r] = o; s += o; ss += o * o; }
#pragma unroll
            for (int o = 1; o <= 8; o <<= 1) { s += __shfl_xor(s, o); ss += __shfl_xor(ss, o); }
            if (l15 == 0) { RED[(c * 2 + (w & 1)) * 2] = s; RED[(c * 2 + (w & 1)) * 2 + 1] = ss; } }
    __syncthreads();
    bf16_t* RO = (bf16_t*)(ws + WS_RO);
#pragma unroll
    for (int mi = 0; mi < 2; ++mi)
#pragma unroll
        for (int r = 0; r < 4; ++r) { const int c = c0 + 16 * mi + 4 * g4 + r; const float s = RED[c * 4] + RED[c * 4 + 2], ss = RED[c * 4 + 1] + RED[c * 4 + 3];
            const float mu = s * (1.0f / 128.0f); const float var = fmaxf(ss * (1.0f / 128.0f) - mu * mu, 0.f); const float rstd = rsqrtf(var + EPS);
            const size_t row = (size_t)n * 128 + c;
#pragma unroll
            for (int ni = 0; ni < 4; ++ni) { const int v = x0 + 16 * ni + l15; const float gn = p.ret_norm_g[(size_t)l * 1024 + h * 128 + v];
                const float gate = bf2f(PJ[(size_t)c * PLD + C_RG + h * 128 + v]);
                RO[row * 1024 + h * 128 + v] = f2bf((a1[mi][ni][r] - mu) * rstd * gn * gate); } }
    __syncthreads();
}
__device__ __forceinline__ void gla_out_unit(const Params& p, unsigned char* ws, LAS unsigned char* lds, int l, int n, int h) {
    const int t = tidx(), w = t >> 6, lane = t & 63, g4 = lane >> 4, l15 = lane & 15, d = t & 127, seg = t >> 7;
    const bf16_t* PJ = (const bf16_t*)(ws + WS_PROJ) + (size_t)n * 128 * PLD;
    LAS unsigned char* Qimg = lds + OFF_Q; LAS unsigned char* KSimg = lds + OFF_KS; LAS unsigned char* Vimg = lds + OFF_V; LAS unsigned char* Pimg = lds + OFF_P;
    LAS float* glrS = (LAS float*)(lds + OFF_X); LAS float* segT = glrS + 128 * 16; LAS float* RED = segT + 4 * 128;
    const bf16_t* PV = (const bf16_t*)(ws + WS_GPREV) + (size_t)(n * 4 + h) * 32768;
    { float bl[32], blast; gla_gate(p, ws, l, n, h, glrS, segT, bl, blast);
#pragma unroll
        for (int i = 0; i < 32; ++i) { const int s = seg * 32 + i; const float q = bf2f(PJ[(size_t)s * PLD + C_GQ + h * 128 + d]), k = bf2f(PJ[(size_t)s * PLD + C_GK + h * 128 + d]);
            *(LAS bf16_t*)(Qimg + s * P128 + d * 2) = f2bf(q * __expf(bl[i])); *(LAS bf16_t*)(KSimg + s * P128 + d * 2) = f2bf(k * __expf(-bl[i])); } }
    stage_tile(Vimg, P128, PJ + C_GV + h * 256, PLD, 128);
    stage_tile(Pimg, P128, PV, 256, 128);
    __syncthreads();
    const int c0 = (w >> 1) * 32, x0 = (w & 1) * 64;
    f32x4 sc[2][4];
#pragma unroll
    for (int a = 0; a < 2; ++a)
#pragma unroll
        for (int b = 0; b < 4; ++b) sc[a][b] = (f32x4){0.f, 0.f, 0.f, 0.f};
    if (x0 <= c0 + 31) {
#pragma unroll
        for (int ks = 0; ks < 4; ++ks) { bf16x8 a[2], b[4];
#pragma unroll
            for (int mi = 0; mi < 2; ++mi) a[mi] = frag_row(Qimg, P128, c0 + 16 * mi, 32 * ks, lane);
#pragma unroll
            for (int ni = 0; ni < 4; ++ni) b[ni] = frag_row(KSimg, P128, x0 + 16 * ni, 32 * ks, lane);
#pragma unroll
            for (int mi = 0; mi < 2; ++mi)
#pragma unroll
                for (int ni = 0; ni < 4; ++ni) sc[mi][ni] = MFMA16(a[mi], b[ni], sc[mi][ni]); } }
    __syncthreads();
#pragma unroll
    for (int mi = 0; mi < 2; ++mi)
#pragma unroll
        for (int ni = 0; ni < 4; ++ni)
#pragma unroll
            for (int r = 0; r < 4; ++r) { const int c = c0 + 16 * mi + 4 * g4 + r, s = x0 + 16 * ni + l15;
                const float v = (c >= s) ? sc[mi][ni][r] : 0.f; *(LAS bf16_t*)(KSimg + c * P128 + s * 2) = f2bf(v); }
    __syncthreads();
    f32x4 oa[2][2][4];
#pragma unroll
    for (int hf = 0; hf < 2; ++hf) {
        if (hf == 1) { __syncthreads(); stage_tile(Vimg, P128, PJ + C_GV + h * 256 + 128, PLD, 128); stage_tile(Pimg, P128, PV + 128, 256, 128); __syncthreads(); }
#pragma unroll
        for (int a = 0; a < 2; ++a)
#pragma unroll
            for (int b = 0; b < 4; ++b) oa[hf][a][b] = (f32x4){0.f, 0.f, 0.f, 0.f};
#pragma unroll
        for (int ks = 0; ks < 4; ++ks) { bf16x8 sa[2], qa[2], vb[4], pb[4];
#pragma unroll
            for (int mi = 0; mi < 2; ++mi) { sa[mi] = frag_row(KSimg, P128, c0 + 16 * mi, 32 * ks, lane); qa[mi] = frag_row(Qimg, P128, c0 + 16 * mi, 32 * ks, lane); }
#pragma unroll
            for (int ni = 0; ni < 4; ++ni) { vb[ni] = frag_tr(Vimg, P128, 32 * ks, x0 + 16 * ni, lane); pb[ni] = frag_tr(Pimg, P128, 32 * ks, x0 + 16 * ni, lane); }
#pragma unroll
            for (int mi = 0; mi < 2; ++mi)
#pragma unroll
                for (int ni = 0; ni < 4; ++ni) { oa[hf][mi][ni] = MFMA16(sa[mi], vb[ni], oa[hf][mi][ni]); oa[hf][mi][ni] = MFMA16(qa[mi], pb[ni], oa[hf][mi][ni]); } }
    }
#pragma unroll
    for (int mi = 0; mi < 2; ++mi)
#pragma unroll
        for (int r = 0; r < 4; ++r) { const int c = c0 + 16 * mi + 4 * g4 + r; float ss = 0.f;
#pragma unroll
            for (int hf = 0; hf < 2; ++hf)
#pragma unroll
                for (int ni = 0; ni < 4; ++ni) { const float o = oa[hf][mi][ni][r]; ss += o * o; }
#pragma unroll
            for (int o = 1; o <= 8; o <<= 1) ss += __shfl_xor(ss, o);
            if (l15 == 0) RED[c * 2 + (w & 1)] = ss; }
    __syncthreads();
    bf16_t* GO = (bf16_t*)(ws + WS_GO);
#pragma unroll
    for (int mi = 0; mi < 2; ++mi)
#pragma unroll
        for (int r = 0; r < 4; ++r) { const int c = c0 + 16 * mi + 4 * g4 + r; const float ss = RED[c * 2] + RED[c * 2 + 1]; const float rstd = rsqrtf(ss * (1.0f / 256.0f) + EPS);
            const size_t row = (size_t)n * 128 + c;
#pragma unroll
            for (int hf = 0; hf < 2; ++hf)
#pragma unroll
                for (int ni = 0; ni < 4; ++ni) { const int v = hf * 128 + x0 + 16 * ni + l15; const float gn = p.gla_norm_g[(size_t)l * 256 + v];
                    const float gate = bf2f(PJ[(size_t)c * PLD + C_GG + h * 256 + v]);
                    GO[row * 1024 + h * 256 + v] = f2bf(oa[hf][mi][ni][r] * rstd * gn * gate); } }
    __syncthreads();
}

constexpr int U_GLA = 65 * 4, U_RET = 65 * 8, U_S5 = 65 * 64, U_ALL = U_GLA + U_RET + U_S5;
__device__ __forceinline__ void phase_states(const Params& p, unsigned char* ws, LAS unsigned char* lds, int l, int bid, int nb) {
    for (int u = bid; u < U_ALL; u += nb) {
        if (u < U_GLA) gla_state_unit(p, ws, lds, l, 1 + u / 4, u % 4);
        else if (u < U_GLA + U_RET) { const int v = u - U_GLA; ret_state_unit(p, ws, lds, 1 + v / 8, v % 8); }
        else { const int v = u - U_GLA - U_RET; s5_unit(p, ws, lds, l, 1 + v / 64, v % 64, 0); }
    }
}
__device__ __forceinline__ void phase_outputs(const Params& p, unsigned char* ws, LAS unsigned char* lds, int l, int bid, int nb) {
    for (int u = bid; u < U_ALL; u += nb) {
        if (u < U_GLA) gla_out_unit(p, ws, lds, l, 1 + u / 4, u % 4);
        else if (u < U_GLA + U_RET) { const int v = u - U_GLA; ret_out_unit(p, ws, lds, l, 1 + v / 8, v % 8); }
        else { const int v = u - U_GLA - U_RET; s5_unit(p, ws, lds, l, 1 + v / 64, v % 64, 1); }
    }
}

__global__ void __launch_bounds__(NT) mega(Params p) {
    extern __shared__ __attribute__((aligned(16))) unsigned char lds_raw[];
    LAS unsigned char* lds = (LAS unsigned char*)lds_raw;
    cg::grid_group grid = cg::this_grid();
    const int bid = blockIdx.x, nb = gridDim.x;
    unsigned char* const p_ws0 = p.ws; unsigned char* ws = p_ws0;
#define FRESH() do { int z_ = 0; asm volatile("" : "+v"(z_)); ws = p_ws0 + __builtin_amdgcn_readfirstlane(z_); } while (0)
#define WSP(T, off) ((T*)(ws + (off)))

    FRESH(); phase_prep(p, ws, lds, bid, nb);
    grid.sync();
    for (int l = 0; l < DEPTH; ++l) {
        FRESH(); phase_rmsnorm(WSP(float, WS_H), p.norm_g + (size_t)l * DM, WSP(bf16_t, WS_HN), bid, nb);
        grid.sync();
        FRESH();
        { const bf16_t* HN = WSP(const bf16_t, WS_HN); const bf16_t* W = WSP(const bf16_t, WS_WIN) + (size_t)l * NIN_T * DM;
            pg8::Gemm g{HN, W, 0, 0, MR, NIN_T, DM}; pg8::StaticOrder S; S.init(MR, NIN_T, nb, bid, 1);
            EpiIn E{WSP(bf16_t, WS_PROJ), WSP(float, WS_GLR), WSP(const float, WS_COS), WSP(const float, WS_SIN)};
            pg8::gemm_phase<EpiIn>(lds, g, S, E); }
        grid.sync();
        FRESH(); phase_states(p, ws, lds, l, bid, nb);
        grid.sync();
        FRESH(); phase_scan(p, ws, l, bid, nb);
        grid.sync();
        FRESH(); phase_outputs(p, ws, lds, l, bid, nb);
        grid.sync();
        FRESH();
        { const bf16_t* A = WSP(const bf16_t, WS_SOPRE); const bf16_t* W = WSP(const bf16_t, WS_WGLU) + (size_t)l * 1024 * 1024;
            pg8::Gemm g{A, W, 0, 0, MR, 1024, 1024}; pg8::StaticOrder S; S.init(MR, 1024, nb, bid, 1);
            EpiGlu E{A, WSP(const bf16_t, WS_PROJ), WSP(bf16_t, WS_SO)};
            pg8::gemm_phase<EpiGlu>(lds, g, S, E); }
        grid.sync();
        FRESH();
        { const bf16_t* W = WSP(const bf16_t, WS_WBR) + (size_t)l * 3 * 2048 * 1024;
            pg8::Gemm g{WSP(const bf16_t, WS_RO), W, WS_GO - WS_RO, (size_t)2048 * 1024 * 2, MR, 2048, 1024};
            static_assert(WS_SO - WS_GO == WS_GO - WS_RO, "branch inputs must be equally spaced");
            pg8::StaticOrder S; S.init(MR, 2048, nb, bid, 3);
            EpiBr E{WSP(const bf16_t, WS_PROJ), WSP(float, WS_YACC), WSP(bf16_t, WS_Y)};
            pg8::gemm_phase<EpiBr>(lds, g, S, E); }
        grid.sync();
        FRESH();
        { const bf16_t* A = WSP(const bf16_t, WS_Y); const bf16_t* W = WSP(const bf16_t, WS_WOUT) + (size_t)l * 2048 * 2048;
            pg8::Gemm g{A, W, 0, 0, MR, 2048, 2048}; pg8::StaticOrder S; S.init(MR, 2048, nb, bid, 1);
            EpiOut E{WSP(float, WS_H)};
            pg8::gemm_phase<EpiOut>(lds, g, S, E); }
        grid.sync();
    }
    FRESH(); phase_final(WSP(const float, WS_H), p.final_g, p.out, bid, nb);
}

extern "C" void kernel_launch(void* const* d_in, const int* in_sizes, int n_in, void* d_out, int out_size, void* d_ws, size_t ws_size, hipStream_t stream) {
    static int grid = 0;
    if (grid == 0) {
        if (n_in != 22 || ws_size < WS_END) { fprintf(stderr, "kernel_launch: unexpected inputs (n_in %d) or workspace too small (%zu < %zu)\n", n_in, ws_size, (size_t)WS_END); grid = -1; return; }
        int dev = 0, cus = 0, per_cu = 0;
        hipGetDevice(&dev); hipDeviceGetAttribute(&cus, hipDeviceAttributeMultiprocessorCount, dev);
        if (hipFuncSetAttribute((const void*)mega, hipFuncAttributeMaxDynamicSharedMemorySize, LDS_BYTES) != hipSuccess) { fprintf(stderr, "kernel_launch: hipFuncSetAttribute failed\n"); grid = -1; return; }
        if (hipOccupancyMaxActiveBlocksPerMultiprocessor(&per_cu, (const void*)mega, NT, LDS_BYTES) != hipSuccess || per_cu < 1) { fprintf(stderr, "kernel_launch: occupancy query gave %d\n", per_cu); per_cu = 1; (void)hipGetLastError(); }
        grid = cus * per_cu;
    }
    if (grid < 0) return;
    Params p{};
    const float** f = (const float**)&p;
    for (int i = 0; i < 22; ++i) f[i] = (const float*)d_in[i];
    p.out = (float*)d_out; p.ws = (unsigned char*)d_ws;
    void* args[] = {&p};
    hipError_t e = hipLaunchCooperativeKernel((const void*)mega, dim3(grid), dim3(NT), args, LDS_BYTES, stream);
    if (e != hipSuccess) fprintf(stderr, "cooperative launch failed: %s (grid %d)\n", hipGetErrorString(e), grid);
}
```

```cpp
#include <hip/hip_runtime.h>
#include <hip/hip_cooperative_groups.h>
#include <cstdio>
namespace cg = cooperative_groups;

#define LAS __attribute__((address_space(3)))
typedef unsigned short bf16_t;
typedef short bf16x8 __attribute__((ext_vector_type(8)));
typedef short s16x4 __attribute__((ext_vector_type(4)));
typedef float f32x4 __attribute__((ext_vector_type(4)));
typedef unsigned u32x4 __attribute__((ext_vector_type(4)));
typedef unsigned u32x2 __attribute__((ext_vector_type(2)));

constexpr int DM = 2048, SEQ = 8192, DEPTH = 4;
constexpr int ROW0 = 240;
constexpr int MR = 8448;
constexpr int NCH = 66;
constexpr int NIN_SRC = 15376;
constexpr int NIN_T = 15616;
constexpr int PLD = 15360;
constexpr int C_RQ = 0, C_RK = 1024, C_RV = 2048, C_RG = 3072, C_GQ = 4096, C_GK = 4608, C_GV = 5120, C_GG = 6144, C_SU = 7168, C_SG = 8192, C_MG = 9216;
constexpr float EPS = 1e-6f;
constexpr int NT = 512;
constexpr int LDS_BYTES = 155648;

constexpr size_t al256(size_t x) { return (x + 255) & ~(size_t)255; }
constexpr size_t WS_H = 0;
constexpr size_t WS_HN = WS_H + al256((size_t)MR * DM * 4);
constexpr size_t WS_PROJ = WS_HN + al256((size_t)MR * DM * 2);
constexpr size_t WS_GLR = WS_PROJ + al256((size_t)MR * PLD * 2);
constexpr size_t WS_WIN = WS_GLR + al256((size_t)MR * 16 * 4);
constexpr size_t WS_WGLU = WS_WIN + al256((size_t)DEPTH * NIN_T * DM * 2);
constexpr size_t WS_WBR = WS_WGLU + al256((size_t)DEPTH * 1024 * 1024 * 2);
constexpr size_t WS_WOUT = WS_WBR + al256((size_t)DEPTH * 3 * 2048 * 1024 * 2);
constexpr size_t WS_COS = WS_WOUT + al256((size_t)DEPTH * 2048 * 2048 * 2);
constexpr size_t WS_SIN = WS_COS + al256((size_t)MR * 64 * 4);
constexpr size_t WS_RKV = WS_SIN + al256((size_t)MR * 64 * 4);
constexpr size_t WS_RPREV = WS_RKV + al256((size_t)NCH * 8 * 128 * 128 * 4);
constexpr size_t WS_GKV = WS_RPREV + al256((size_t)NCH * 8 * 128 * 128 * 2);
constexpr size_t WS_GPREV = WS_GKV + al256((size_t)NCH * 4 * 128 * 256 * 4);
constexpr size_t WS_GDEC = WS_GPREV + al256((size_t)NCH * 4 * 128 * 256 * 2);
constexpr size_t WS_S5E = WS_GDEC + al256((size_t)NCH * 4 * 128 * 4);
constexpr size_t WS_S5H = WS_S5E + al256((size_t)NCH * 64 * 64 * 2 * 4);
constexpr size_t WS_RO = WS_S5H + al256((size_t)NCH * 64 * 64 * 2 * 4);
constexpr size_t WS_GO = WS_RO + al256((size_t)MR * 1024 * 2);
constexpr size_t WS_SO = WS_GO + al256((size_t)MR * 1024 * 2);
constexpr size_t WS_SOPRE = WS_SO + al256((size_t)MR * 1024 * 2);
constexpr size_t WS_Y = WS_SOPRE + al256((size_t)MR * 1024 * 2);
constexpr size_t WS_YACC = WS_Y + al256((size_t)MR * DM * 2);
constexpr size_t WS_SS = WS_YACC + al256((size_t)MR * DM * 4);
constexpr size_t WS_BAR = WS_SS + al256((size_t)(DEPTH + 1) * MR * 32 * 4);
constexpr size_t WS_END = WS_BAR + 3456 * 4;

struct Params {
    const float* x; const float* meta; const float* norm_g; const float* w_in; const float* ret_norm_g;
    const float* gla_w_a; const float* gla_b_a; const float* gla_norm_g;
    const float* s5_lre; const float* s5_lim; const float* s5_logdt; const float* s5_bre; const float* s5_bim; const float* s5_cre; const float* s5_cim;
    const float* s5_d; const float* s5_wglu; const float* w_br_ret; const float* w_br_gla; const float* w_br_s5; const float* w_out; const float* final_g;
    float* out; unsigned char* ws;
};

__device__ __forceinline__ unsigned cvt_pk_bf16(float lo, float hi) { unsigned r; asm("v_cvt_pk_bf16_f32 %0, %1, %2" : "=v"(r) : "v"(lo), "v"(hi)); return r; }
__device__ __forceinline__ bf16_t f2bf(float f) { return (bf16_t)(cvt_pk_bf16(f, 0.f) & 0xffffu); }
__device__ __forceinline__ float bf2f(bf16_t b) { return __uint_as_float(((unsigned)b) << 16); }
__device__ __forceinline__ float bflo(unsigned w) { return __uint_as_float(w << 16); }
__device__ __forceinline__ float bfhi(unsigned w) { return __uint_as_float(w & 0xffff0000u); }
__device__ __forceinline__ float sigmoidf_(float x) { return 1.0f / (1.0f + __expf(-x)); }
__device__ __forceinline__ float siluf_(float x) { return x / (1.0f + __expf(-x)); }
__device__ __forceinline__ float logsigmoidf_(float x) { return fminf(x, 0.f) - log1pf(__expf(-fabsf(x))); }
__device__ __forceinline__ float geluf_(float x) { const float z = 0.7978845608028654f * (x + 0.044715f * x * x * x); const float t = 1.0f - 2.0f / (__expf(2.0f * z) + 1.0f); return 0.5f * x * (1.0f + t); }
__device__ __forceinline__ void sincos_red(float ang, float& s, float& c) {
    const float n = rintf(ang * 0.15915494309189535f);
    float r = fmaf(-n, 6.2831854820251465f, ang);
    r = fmaf(-n, -1.7484556000744883e-7f, r);
    const float rev = r * 0.15915494309189535f;
    s = __builtin_amdgcn_sinf(rev); c = __builtin_amdgcn_cosf(rev);
}
__device__ __forceinline__ float ret_log_gamma(int h) { return log1pf(-exp2f(-5.0f - (float)h)); }

__device__ __forceinline__ bf16x8 frag_row(const LAS unsigned char* img, int pitch, int r0, int k0, int lane) {
    return *(const LAS bf16x8*)(img + (r0 + (lane & 15)) * pitch + (k0 + 8 * (lane >> 4)) * 2);
}
__device__ __forceinline__ bf16x8 frag_tr(const LAS unsigned char* img, int pitch, int k0, int c0, int lane) {
    const int g = lane >> 4, q = (lane & 15) >> 2, p = lane & 3;
    const LAS unsigned char* a = img + (k0 + 8 * g + q) * pitch + (c0 + 4 * p) * 2;
    const s16x4 lo = __builtin_amdgcn_ds_read_tr16_b64_v4i16((LAS s16x4*)a);
    const s16x4 hi = __builtin_amdgcn_ds_read_tr16_b64_v4i16((LAS s16x4*)(a + 4 * pitch));
    bf16x8 r; r[0] = lo[0]; r[1] = lo[1]; r[2] = lo[2]; r[3] = lo[3]; r[4] = hi[0]; r[5] = hi[1]; r[6] = hi[2]; r[7] = hi[3]; return r;
}
__device__ __forceinline__ int tidx() { int t = (int)__builtin_amdgcn_workitem_id_x(); asm volatile("" : "+v"(t)); return t; }
#define MFMA16(a, b, c) __builtin_amdgcn_mfma_f32_16x16x32_bf16((a), (b), (c), 0, 0, 0)


#define XB_TMO      128
#define XB_XCNT(j)  (256  + 64 * (j))
#define XB_XSUB(j)  (1280 + 64 * (j))
#define XB_XGEN(j)  (2304 + 64 * (j))
#define XB_TOP      3328
#define XB_TOPGEN   3392
#define XCD_BAR_WORDS 3456
#define XB_SPIN_CAP (1u << 22)
__device__ __forceinline__ unsigned xb_ld(unsigned* p)              { return __hip_atomic_load(p, __ATOMIC_RELAXED, __HIP_MEMORY_SCOPE_AGENT); }
__device__ __forceinline__ unsigned xb_add(unsigned* p, unsigned v) { return __hip_atomic_fetch_add(p, v, __ATOMIC_RELAXED, __HIP_MEMORY_SCOPE_AGENT); }
__device__ __forceinline__ unsigned xb_xcc_id() { return (unsigned)__builtin_amdgcn_s_getreg((3 << 11) | 20) & 0xFu; }
#define XB_SPIN(cond, bar) do { unsigned _sp = 0; while (cond) { __builtin_amdgcn_s_sleep(1); \
    if ((++_sp & 255u) == 0u) { if (xb_ld(&(bar)[XB_TMO])) break; if (_sp > XB_SPIN_CAP) { atomicAdd(&(bar)[XB_TMO], 1u); break; } } } } while (0)
struct XcdBarrier { unsigned* bar; unsigned x; volatile LAS unsigned* st; };
__device__ __forceinline__ XcdBarrier xcd_barrier_post(unsigned* bar, volatile LAS unsigned* st) {
    XcdBarrier b; b.bar = bar; b.x = xb_xcc_id(); b.st = st;
    if (tidx() == 0) (void)xb_add(&bar[XB_XCNT(b.x)], 1u);
    return b;
}
__device__ __forceinline__ void xcd_barrier_complete(unsigned* bar, unsigned x, unsigned& nloc, unsigned& nx) {
    const unsigned G = gridDim.x * gridDim.y * gridDim.z;
    unsigned sum, cnt, mine, sp = 0u;
    for (;;) {
        sum = 0u; cnt = 0u; mine = 0u;
#pragma unroll
        for (unsigned j = 0; j < 16; ++j) { const unsigned c = xb_ld(&bar[XB_XCNT(j)]); sum += c; cnt += (c > 0u) ? 1u : 0u; mine = (j == x) ? c : mine; }
        if (sum == G) break;
        __builtin_amdgcn_s_sleep(1);
        if ((++sp & 255u) == 0u) { if (xb_ld(&bar[XB_TMO])) break; if (sp > XB_SPIN_CAP) { atomicAdd(&bar[XB_TMO], 1u); break; } }
    }
    nloc = mine > 0u ? mine : 1u; nx = cnt > 0u ? cnt : 1u;
}
__device__ __forceinline__ void xcd_barrier(const XcdBarrier& b) {
    asm volatile("s_waitcnt vmcnt(0)" ::: "memory");
    __syncthreads();
    if (tidx() == 0) {
        unsigned* bar = b.bar;
        __builtin_amdgcn_s_waitcnt(0);
        unsigned nloc = b.st[0], nx = b.st[1];
        if (nloc == 0u) { xcd_barrier_complete(bar, b.x, nloc, nx); b.st[0] = nloc; b.st[1] = nx; }
        const unsigned old = xb_add(&bar[XB_XSUB(b.x)], 1u);
        const unsigned gen = old / nloc;
        if (old + 1u == (gen + 1u) * nloc) {
            __builtin_amdgcn_fence(__ATOMIC_RELEASE, "agent");
            asm volatile("s_waitcnt vmcnt(0)" ::: "memory");
            const unsigned og = xb_add(&bar[XB_TOP], 1u);
            const unsigned tg = og / nx;
            if (og + 1u == (tg + 1u) * nx) xb_add(&bar[XB_TOPGEN], 1u);
            else XB_SPIN(xb_ld(&bar[XB_TOPGEN]) == tg, bar);
            __builtin_amdgcn_fence(__ATOMIC_ACQUIRE, "agent");
            xb_add(&bar[XB_XGEN(b.x)], 1u);
            asm volatile("s_waitcnt vmcnt(0)" ::: "memory");
        } else {
            XB_SPIN(xb_ld(&bar[XB_XGEN(b.x)]) == gen, bar);
            __builtin_amdgcn_fence(__ATOMIC_ACQUIRE, "agent");
            asm volatile("s_waitcnt vmcnt(0)" ::: "memory");
        }
    }
    __syncthreads();
}

namespace pg8 {
constexpr int BM = 256, BK = 64, HALF = 128, HTB = HALF * BK * 2, STAGE_BYTES = 8 * HTB, NXCD = 8, WGM = 8;
__host__ __device__ __forceinline__ int lds_byte(int r, int c) { const int st = (r >> 4) * 2 + (c >> 5), rr = r & 15, cc = c & 31, ob = rr * 64 + cc * 2; return st * 1024 + (ob ^ (((ob >> 9) & 1) << 5)); }
__host__ __device__ __forceinline__ void stage_rc(int b, int& R, int& C) { const int st = b / 1024, sb = b % 1024, swz = sb ^ (((sb >> 9) & 1) << 5); R = (st >> 1) * 16 + swz / 64; C = (st & 1) * 32 + (swz % 64) / 2; }
__host__ __device__ __forceinline__ int perm32(int rho) { const int n = rho >> 4, i = rho & 15; return 8 * (i >> 2) + 4 * n + (i & 3); }

struct Unit { int pm, pn, sel; };
struct Gemm { const bf16_t* A; const bf16_t* Bt; size_t selA, selB; int M, N, K; };
__device__ __forceinline__ const char* selA(const Gemm& g, int s) { return (const char*)g.A + (size_t)s * g.selA; }
__device__ __forceinline__ const char* selB(const Gemm& g, int s) { return (const char*)g.Bt + (size_t)s * g.selB; }

struct StaticOrder {
    int nM, nN, nwg, G, c, nsel;
    __device__ void init(int M, int N, int G_, int c_, int nsel_) { nM = M / BM; nN = N / BM; nwg = nM * nN; G = G_; c = c_; nsel = nsel_; }
    __device__ bool next(int i, Unit& u) const {
        const int it = i / nsel; u.sel = i - it * nsel;
        const long L = (long)it * G + c; if (L >= nwg) return false;
        int wgid = (int)L; { const int q = nwg / NXCD, r = nwg % NXCD, xcd = wgid % NXCD, off = wgid / NXCD; wgid = (xcd < r ? xcd * (q + 1) : r * (q + 1) + (xcd - r) * q) + off; }
        const int nig = WGM * nN, gid = wgid / nig, fm = gid * WGM, gsz = (nM - fm) < WGM ? (nM - fm) : WGM;
        u.pm = fm + ((wgid % nig) % gsz); u.pn = (wgid % nig) / gsz; return true;
    }
};

template <class Epi>
__device__ __forceinline__ void gemm_phase(LAS unsigned char* lds, const Gemm g, const StaticOrder& S, const Epi& E) {
    const int tid = tidx(), wid = __builtin_amdgcn_readfirstlane(tid >> 6), lane = tid & 63, wr = wid >> 2, wc = wid & 3, fr = lane & 15, fq = lane >> 4;
    const int K = g.K, nt = K / BK;
    unsigned voffA[2], voffB[2];
#pragma unroll
    for (int i = 0; i < 2; ++i) { int R, C; stage_rc(tid * 16 + i * 8192, R, C); const int Rb = (R & ~31) + perm32(R & 31);
        voffA[i] = (unsigned)(R * K + C) * 2u; voffB[i] = (unsigned)(Rb * K + C) * 2u; }
    const size_t kstep = (size_t)(BK * 2);
    const size_t hstep = (size_t)HALF * K * 2;
    const size_t tstep = 2 * hstep;
    const unsigned ldsw = (unsigned)wid * 1024u;
    const int aoff = lds_byte(wr * 64 + fr, fq * 8), boff = lds_byte(wc * 32 + fr, fq * 8);
#define PG8_SA(b, h) (((b) * 2 + (h)) * HTB)
#define PG8_SB(b, h) ((4 + (b) * 2 + (h)) * HTB)
#define PG8_STAGE(bufoff, gbase, voff) do { _Pragma("unroll") for (int _i = 0; _i < 2; ++_i) \
        __builtin_amdgcn_global_load_lds((const unsigned*)((const char*)(gbase) + (voff)[_i]), (LAS unsigned*)(lds + (bufoff) + ldsw + _i * 8192), 16, 0, 0); } while (0)
#define PG8_LDA(dst, b, h) do { _Pragma("unroll") for (int m = 0; m < 4; ++m) _Pragma("unroll") for (int k = 0; k < 2; ++k) dst[m][k] = *(const LAS bf16x8*)(lds + PG8_SA(b, h) + aoff + m * 2048 + k * 1024); } while (0)
#define PG8_LDB(dst, b, h) do { _Pragma("unroll") for (int n = 0; n < 2; ++n) _Pragma("unroll") for (int k = 0; k < 2; ++k) dst[n][k] = *(const LAS bf16x8*)(lds + PG8_SB(b, h) + boff + n * 2048 + k * 1024); } while (0)
#define PG8_MMA(ai, bj, At, Bt) do { __builtin_amdgcn_s_setprio(1); _Pragma("unroll") for (int m = 0; m < 4; ++m) _Pragma("unroll") for (int n = 0; n < 2; ++n) _Pragma("unroll") for (int k = 0; k < 2; ++k) \
        acc[ai][bj][m][n] = __builtin_amdgcn_mfma_f32_16x16x32_bf16(Bt[n][k], At[m][k], acc[ai][bj][m][n], 0, 0, 0); __builtin_amdgcn_s_setprio(0); } while (0)
#define PG8_WAIT_V(n) asm volatile("s_waitcnt vmcnt(" #n ")" ::: "memory")
#define PG8_WAIT_L(n) asm volatile("s_waitcnt lgkmcnt(" #n ")" ::: "memory")
#define PG8_BAR __builtin_amdgcn_s_barrier()
#define PG8_SCHED __builtin_amdgcn_sched_barrier(0)
    Unit cur, nxt; int ui = 0;
    if (!S.next(0, cur)) return;
    f32x4 acc[2][2][4][2];
#pragma unroll
    for (int a = 0; a < 2; ++a)
#pragma unroll
        for (int b = 0; b < 2; ++b)
#pragma unroll
            for (int m = 0; m < 4; ++m)
#pragma unroll
                for (int n = 0; n < 2; ++n) acc[a][b][m][n] = (f32x4){0.f, 0.f, 0.f, 0.f};
    bf16x8 At[4][2], B0[2][2], B1[2][2];
    const char* cA = selA(g, cur.sel) + (size_t)cur.pm * tstep; const char* cB = selB(g, cur.sel) + (size_t)cur.pn * tstep;
    PG8_STAGE(PG8_SB(0, 0), cB, voffB); PG8_STAGE(PG8_SA(0, 0), cA, voffA); PG8_STAGE(PG8_SB(0, 1), cB + hstep, voffB); PG8_STAGE(PG8_SA(0, 1), cA + hstep, voffA);
    if (wr == 1) PG8_BAR;
    PG8_WAIT_V(4); PG8_BAR;
    PG8_STAGE(PG8_SB(1, 0), cB + kstep, voffB); PG8_STAGE(PG8_SA(1, 0), cA + kstep, voffA); PG8_STAGE(PG8_SB(1, 1), cB + hstep + kstep, voffB);
    PG8_WAIT_V(6); PG8_BAR;
    for (;;) {
        const bool has_next = S.next(ui + 1, nxt);
        const char* nA = has_next ? selA(g, nxt.sel) + (size_t)nxt.pm * tstep : cA; const char* nB = has_next ? selB(g, nxt.sel) + (size_t)nxt.pn * tstep : cB;
        for (int t = 0; t < nt; t += 2) {
            const bool last = (t == nt - 2);
            const char* a1 = cA + (size_t)(t + 1) * kstep;
            const char* a2 = last ? nA : cA + (size_t)(t + 2) * kstep; const char* b2 = last ? nB : cB + (size_t)(t + 2) * kstep;
            const char* a3 = a2 + kstep; const char* b3 = b2 + kstep;
            PG8_LDB(B0, 0, 0); PG8_SCHED; PG8_LDA(At, 0, 0); PG8_STAGE(PG8_SA(1, 1), a1 + hstep, voffA);
            PG8_WAIT_L(8); PG8_BAR; PG8_WAIT_L(0); PG8_MMA(0, 0, At, B0); PG8_BAR; PG8_SCHED;
            PG8_LDB(B1, 0, 1); PG8_STAGE(PG8_SB(0, 0), b2, voffB);
            PG8_BAR; PG8_WAIT_L(0); PG8_MMA(0, 1, At, B1); PG8_BAR;
            PG8_LDA(At, 0, 1); PG8_STAGE(PG8_SA(0, 0), a2, voffA);
            PG8_BAR; PG8_WAIT_L(0); PG8_MMA(1, 0, At, B0); PG8_BAR; PG8_SCHED;
            PG8_STAGE(PG8_SB(0, 1), b2 + hstep, voffB);
            PG8_WAIT_V(6); PG8_BAR; PG8_MMA(1, 1, At, B1); PG8_BAR;
            PG8_LDB(B0, 1, 0); PG8_SCHED; PG8_LDA(At, 1, 0); PG8_STAGE(PG8_SA(0, 1), a2 + hstep, voffA);
            PG8_WAIT_L(8); PG8_BAR; PG8_WAIT_L(0); PG8_MMA(0, 0, At, B0); PG8_BAR; PG8_SCHED;
            PG8_LDB(B1, 1, 1); PG8_STAGE(PG8_SB(1, 0), b3, voffB);
            PG8_BAR; PG8_WAIT_L(0); PG8_MMA(0, 1, At, B1); PG8_BAR;
            PG8_LDA(At, 1, 1); PG8_STAGE(PG8_SA(1, 0), a3, voffA);
            PG8_BAR; PG8_WAIT_L(0); PG8_MMA(1, 0, At, B0); PG8_BAR; PG8_SCHED;
            PG8_STAGE(PG8_SB(1, 1), b3 + hstep, voffB);
            PG8_WAIT_V(6); PG8_BAR; PG8_MMA(1, 1, At, B1); PG8_BAR;
        }
        E(acc, cur, wr, wc, fr, fq);
        if (!has_next) break;
#pragma unroll
        for (int a = 0; a < 2; ++a)
#pragma unroll
            for (int b = 0; b < 2; ++b)
#pragma unroll
                for (int m = 0; m < 4; ++m)
#pragma unroll
                    for (int n = 0; n < 2; ++n) acc[a][b][m][n] = (f32x4){0.f, 0.f, 0.f, 0.f};
        cur = nxt; cA = nA; cB = nB; ++ui;
    }
    PG8_WAIT_V(0);
    if (wr == 0) PG8_BAR;
    PG8_BAR;
#undef PG8_SA
#undef PG8_SB
#undef PG8_STAGE
#undef PG8_LDA
#undef PG8_LDB
#undef PG8_MMA
#undef PG8_WAIT_V
#undef PG8_WAIT_L
#undef PG8_BAR
#undef PG8_SCHED
}
}

typedef f32x4 AccT[2][2][4][2];
__device__ __forceinline__ u32x4 pack8(const f32x4 a, const f32x4 b) { u32x4 w; w.x = cvt_pk_bf16(a[0], a[1]); w.y = cvt_pk_bf16(a[2], a[3]); w.z = cvt_pk_bf16(b[0], b[1]); w.w = cvt_pk_bf16(b[2], b[3]); return w; }
__device__ __forceinline__ void unpack8(const u32x4 w, f32x4& a, f32x4& b) { a = (f32x4){bflo(w.x), bfhi(w.x), bflo(w.y), bfhi(w.y)}; b = (f32x4){bflo(w.z), bfhi(w.z), bflo(w.w), bfhi(w.w)}; }

__device__ __forceinline__ float row_rs(const float* part, int r, int fq) {
    const f32x4 a = *(const f32x4*)(part + (size_t)r * 32 + fq * 8), b = *(const f32x4*)(part + (size_t)r * 32 + fq * 8 + 4);
    float s = (a[0] + a[1]) + (a[2] + a[3]) + (b[0] + b[1]) + (b[2] + b[3]); s += __shfl_xor(s, 16); s += __shfl_xor(s, 32);
    return rsqrtf(s * (1.0f / DM) + EPS);
}
struct EpiIn {
    bf16_t* P; float* glr; const float* cosT; const float* sinT; const float* ss;
    __device__ __forceinline__ void operator()(const AccT& acc, const pg8::Unit& u, int wr, int wc, int fr, int fq) const {
        const int pn = u.pn; const int row0 = u.pm * 256 + wr * 64 + fr;
        int mode = 0; float scale = 1.0f;
        if (pn < 8) { mode = 1; scale = pn >= 4 ? 0.08838834764831845f : 1.0f; }
        else if ((pn >= 12 && pn < 16) || (pn >= 24 && pn < 28) || (pn >= 32 && pn < 36)) mode = 2;
        else if (pn >= 36 && pn < 60) mode = 3;
        else if (pn == 60) mode = 4;
        else if (pn == 16 || pn == 17) scale = 0.08838834764831845f;
        if (mode == 4) {
            if (wc == 0) {
#pragma unroll
                for (int ai = 0; ai < 2; ++ai)
#pragma unroll
                    for (int m = 0; m < 4; ++m) { const int r = row0 + ai * 128 + m * 16; const float rs = row_rs(ss, r, fq);
                        if (fq < 2) { float* gp = glr + (size_t)r * 16 + 8 * fq; *(f32x4*)gp = acc[ai][0][m][0] * rs; *(f32x4*)(gp + 4) = acc[ai][0][m][1] * rs; } }
            }
            return;
        }
        const int i4 = 4 * (4 * wc + fq);
#pragma unroll
        for (int ai = 0; ai < 2; ++ai)
#pragma unroll
            for (int m = 0; m < 4; ++m) {
                const int r = row0 + ai * 128 + m * 16; const float rs = row_rs(ss, r, fq);
                bf16_t* rowp = P + (size_t)r * PLD + pn * 256 + wc * 32 + 8 * fq;
                f32x4 cs = (f32x4){1.f, 1.f, 1.f, 1.f}, sn = (f32x4){0.f, 0.f, 0.f, 0.f};
                if (mode == 1) { const int pos = r >= ROW0 ? r - ROW0 : 0; cs = *(const f32x4*)(cosT + (size_t)pos * 64 + i4); sn = *(const f32x4*)(sinT + (size_t)pos * 64 + i4); }
#pragma unroll
                for (int bj = 0; bj < 2; ++bj) {
                    f32x4 v0 = acc[ai][bj][m][0] * rs, v1 = acc[ai][bj][m][1] * rs;
                    if (mode == 1) { const f32x4 o1 = v0 * cs - v1 * sn, o2 = v0 * sn + v1 * cs; v0 = o1 * scale; v1 = o2 * scale; }
                    else if (mode == 2) {
#pragma unroll
                        for (int j = 0; j < 4; ++j) { v0[j] = siluf_(v0[j]); v1[j] = siluf_(v1[j]); } }
                    else if (mode == 3) {
#pragma unroll
                        for (int j = 0; j < 4; ++j) { v0[j] = sigmoidf_(v0[j]); v1[j] = sigmoidf_(v1[j]); } }
                    else { v0 = v0 * scale; v1 = v1 * scale; }
                    *(u32x4*)(rowp + bj * 128) = pack8(v0, v1);
                }
            }
    }
};
struct EpiGlu {
    const bf16_t* sopre; const bf16_t* P; bf16_t* so;
    __device__ __forceinline__ void operator()(const AccT& acc, const pg8::Unit& u, int wr, int wc, int fr, int fq) const {
        const int row0 = u.pm * 256 + wr * 64 + fr, col0 = u.pn * 256 + wc * 32 + 8 * fq;
#pragma unroll
        for (int ai = 0; ai < 2; ++ai)
#pragma unroll
            for (int m = 0; m < 4; ++m) { const int r = row0 + ai * 128 + m * 16;
#pragma unroll
                for (int bj = 0; bj < 2; ++bj) { const int c = col0 + bj * 128;
                    const u32x4 sp = *(const u32x4*)(sopre + (size_t)r * 1024 + c), gt = *(const u32x4*)(P + (size_t)r * PLD + C_SG + c);
                    f32x4 s0, s1, g0, g1; unpack8(sp, s0, s1); unpack8(gt, g0, g1);
                    f32x4 v0 = acc[ai][bj][m][0], v1 = acc[ai][bj][m][1];
#pragma unroll
                    for (int j = 0; j < 4; ++j) { v0[j] = s0[j] * sigmoidf_(v0[j]) * g0[j]; v1[j] = s1[j] * sigmoidf_(v1[j]) * g1[j]; }
                    *(u32x4*)(so + (size_t)r * 1024 + c) = pack8(v0, v1); } }
    }
};
struct EpiBr {
    const bf16_t* P; float* yacc; bf16_t* y;
    __device__ __forceinline__ void operator()(const AccT& acc, const pg8::Unit& u, int wr, int wc, int fr, int fq) const {
        const int row0 = u.pm * 256 + wr * 64 + fr, col0 = u.pn * 256 + wc * 32 + 8 * fq; const int sel = u.sel;
#pragma unroll
        for (int ai = 0; ai < 2; ++ai)
#pragma unroll
            for (int m = 0; m < 4; ++m) { const int r = row0 + ai * 128 + m * 16;
#pragma unroll
                for (int bj = 0; bj < 2; ++bj) { const int c = col0 + bj * 128;
                    const u32x4 gt = *(const u32x4*)(P + (size_t)r * PLD + C_MG + sel * 2048 + c);
                    f32x4 g0, g1; unpack8(gt, g0, g1);
                    f32x4 v0 = acc[ai][bj][m][0] * g0, v1 = acc[ai][bj][m][1] * g1;
                    float* yp = yacc + (size_t)r * DM + c;
                    if (sel > 0) { v0 = v0 + *(const f32x4*)yp; v1 = v1 + *(const f32x4*)(yp + 4); }
                    if (sel < 2) { *(f32x4*)yp = v0; *(f32x4*)(yp + 4) = v1; }
                    else *(u32x4*)(y + (size_t)r * DM + c) = pack8(v0, v1); } }
    }
};
struct EpiOut {
    float* H; bf16_t* HN; const float* gnext; float* ssn;
    __device__ __forceinline__ void operator()(const AccT& acc, const pg8::Unit& u, int wr, int wc, int fr, int fq) const {
        const int row0 = u.pm * 256 + wr * 64 + fr, col0 = u.pn * 256 + wc * 32 + 8 * fq;
#pragma unroll
        for (int ai = 0; ai < 2; ++ai)
#pragma unroll
            for (int m = 0; m < 4; ++m) { const int r = row0 + ai * 128 + m * 16; float sq = 0.f;
#pragma unroll
                for (int bj = 0; bj < 2; ++bj) { const int c = col0 + bj * 128; float* hp = H + (size_t)r * DM + c;
                    const f32x4 a = *(const f32x4*)hp + acc[ai][bj][m][0], b = *(const f32x4*)(hp + 4) + acc[ai][bj][m][1];
                    *(f32x4*)hp = a; *(f32x4*)(hp + 4) = b;
                    sq += a[0] * a[0] + a[1] * a[1] + a[2] * a[2] + a[3] * a[3] + b[0] * b[0] + b[1] * b[1] + b[2] * b[2] + b[3] * b[3];
                    if (gnext) { const f32x4 g0 = *(const f32x4*)(gnext + c), g1 = *(const f32x4*)(gnext + c + 4); *(u32x4*)(HN + (size_t)r * DM + c) = pack8(a * g0, b * g1); } }
                sq += __shfl_xor(sq, 16); sq += __shfl_xor(sq, 32);
                if (fq == 0) ssn[(size_t)r * 32 + u.pn * 4 + wc] = sq; }
    }
};

__device__ __forceinline__ int win_dst_row(int c) {
    if (c < 2048) { const int hd = c >> 7, d = c & 127, i = d & 63, half = d >> 6; return (hd << 7) + 8 * (i >> 2) + 4 * half + (i & 3); }
    if (c < 7168) return c;
    if (c < 7184) return 15360 + (c - 7168);
    return c - 16;
}
__device__ __forceinline__ void cvt_tile(LAS unsigned char* lds, const float* src, int K, int Ns, bf16_t* dst, int k0, int n0, bool winmap) {
    const int t = tidx(); LAS bf16_t* T = (LAS bf16_t*)lds;
    { const int kk = t >> 5, n4 = (t & 31) * 4;
        f32x4 v[4];
#pragma unroll
        for (int i = 0; i < 4; ++i) { const int k = kk + 16 * i; v[i] = (n0 + n4 < Ns) ? *(const f32x4*)(src + (size_t)(k0 + k) * Ns + n0 + n4) : (f32x4){0.f, 0.f, 0.f, 0.f}; }
#pragma unroll
        for (int i = 0; i < 4; ++i) { const int k = kk + 16 * i;
#pragma unroll
            for (int j = 0; j < 4; ++j) T[(n4 + j) * 72 + k] = f2bf(v[i][j]); } }
    __syncthreads();
    { const int n = t >> 2, seg = t & 3;
        if (n0 + n < Ns) { const int dr = winmap ? win_dst_row(n0 + n) : (n0 + n);
            const u32x4 a = *(const LAS u32x4*)(lds + n * 144 + seg * 32), b = *(const LAS u32x4*)(lds + n * 144 + seg * 32 + 16);
            bf16_t* dp = dst + (size_t)dr * K + k0 + seg * 16; *(u32x4*)dp = a; *(u32x4*)(dp + 8) = b; } }
    __syncthreads();
}
__device__ __forceinline__ void phase_prep(const Params& p, unsigned char* ws, LAS unsigned char* lds, int bid, int nb) {
    const int t = tidx();
    constexpr int T_IN = 32 * 121, T_GLU = 16 * 8, T_BR = 16 * 16, T_OUT = 32 * 16, T_L = T_IN + T_GLU + 3 * T_BR + T_OUT;
    for (int tile = bid; tile < DEPTH * T_L; tile += nb) {
        const int l = tile / T_L; int r = tile - l * T_L;
        if (r < T_IN) { cvt_tile(lds, p.w_in + (size_t)l * DM * NIN_SRC, DM, NIN_SRC, (bf16_t*)(ws + WS_WIN) + (size_t)l * NIN_T * DM, (r / 121) * 64, (r % 121) * 128, true); continue; }
        r -= T_IN;
        if (r < T_GLU) { cvt_tile(lds, p.s5_wglu + (size_t)l * 1024 * 1024, 1024, 1024, (bf16_t*)(ws + WS_WGLU) + (size_t)l * 1024 * 1024, (r / 8) * 64, (r % 8) * 128, false); continue; }
        r -= T_GLU;
        if (r < 3 * T_BR) { const int b = r / T_BR; r -= b * T_BR; const float* src = (b == 0 ? p.w_br_ret : (b == 1 ? p.w_br_gla : p.w_br_s5)) + (size_t)l * 1024 * 2048;
            cvt_tile(lds, src, 1024, 2048, (bf16_t*)(ws + WS_WBR) + (size_t)(l * 3 + b) * 2048 * 1024, (r / 16) * 64, (r % 16) * 128, false); continue; }
        r -= 3 * T_BR;
        cvt_tile(lds, p.w_out + (size_t)l * 2048 * 2048, 2048, 2048, (bf16_t*)(ws + WS_WOUT) + (size_t)l * 2048 * 2048, (r / 16) * 64, (r % 16) * 128, false);
    }
    const size_t gtid = (size_t)bid * NT + t, gsz = (size_t)nb * NT;
    for (size_t i = gtid; i < (size_t)DEPTH * 240 * DM / 8; i += gsz) { const size_t l = i / (240 * DM / 8), o = i % (240 * DM / 8);
        *(u32x4*)((bf16_t*)(ws + WS_WIN) + (l * NIN_T + 15376) * DM + o * 8) = (u32x4){0u, 0u, 0u, 0u}; }
    { float* H = (float*)(ws + WS_H); bf16_t* HN = (bf16_t*)(ws + WS_HN); float* SS = (float*)(ws + WS_SS); const int wave = t >> 6, lane = t & 63;
        for (int r = bid * 8 + wave; r < MR; r += nb * 8) { f32x4 v[8]; float ss = 0.f;
#pragma unroll
            for (int j = 0; j < 8; ++j) { const int c = (j * 64 + lane) * 4; v[j] = (f32x4){0.f, 0.f, 0.f, 0.f};
                if (r >= 256) v[j] = *(const f32x4*)(p.x + (size_t)(r - 256) * DM + c); else if (r >= ROW0) v[j] = *(const f32x4*)(p.meta + (size_t)(r - ROW0) * DM + c);
                ss += v[j][0] * v[j][0] + v[j][1] * v[j][1] + v[j][2] * v[j][2] + v[j][3] * v[j][3]; }
#pragma unroll
            for (int o = 32; o >= 1; o >>= 1) ss += __shfl_xor(ss, o);
#pragma unroll
            for (int j = 0; j < 8; ++j) { const int c = (j * 64 + lane) * 4; const f32x4 gv = *(const f32x4*)(p.norm_g + c); const f32x4 o = v[j] * gv;
                *(f32x4*)(H + (size_t)r * DM + c) = v[j]; u32x2 w; w.x = cvt_pk_bf16(o[0], o[1]); w.y = cvt_pk_bf16(o[2], o[3]); *(u32x2*)(HN + (size_t)r * DM + c) = w; }
            if (lane < 32) SS[(size_t)r * 32 + lane] = lane == 0 ? ss : 0.f; } }
    float* cosT = (float*)(ws + WS_COS); float* sinT = (float*)(ws + WS_SIN);
    for (size_t i = gtid; i < (size_t)MR * 64; i += gsz) { const int pos = (int)(i >> 6), k = (int)(i & 63);
        const float inv = exp2f(-(float)k * (13.287712379549449f / 64.0f)); const float ang = (float)pos * inv; float s, c; sincos_red(ang, s, c); cosT[i] = c; sinT[i] = s; }
    for (size_t i = gtid; i < (size_t)128 * 1024 / 8; i += gsz) { const u32x4 z = (u32x4){0u, 0u, 0u, 0u};
        *(u32x4*)((bf16_t*)(ws + WS_RO) + i * 8) = z; *(u32x4*)((bf16_t*)(ws + WS_GO) + i * 8) = z; *(u32x4*)((bf16_t*)(ws + WS_SOPRE) + i * 8) = z; }
}

__device__ __forceinline__ void phase_rmsnorm(const float* H, const float* g, bf16_t* HN, int bid, int nb) {
    const int wave = tidx() >> 6, lane = tidx() & 63;
    for (int r = bid * 8 + wave; r < MR; r += nb * 8) {
        const float* hp = H + (size_t)r * DM; f32x4 v[8]; float ss = 0.f;
#pragma unroll
        for (int j = 0; j < 8; ++j) { v[j] = *(const f32x4*)(hp + (j * 64 + lane) * 4); ss += v[j][0] * v[j][0] + v[j][1] * v[j][1] + v[j][2] * v[j][2] + v[j][3] * v[j][3]; }
#pragma unroll
        for (int o = 32; o >= 1; o >>= 1) ss += __shfl_xor(ss, o);
        const float rs = rsqrtf(ss * (1.0f / DM) + EPS);
#pragma unroll
        for (int j = 0; j < 8; ++j) { const int c = (j * 64 + lane) * 4; const f32x4 gv = *(const f32x4*)(g + c); const f32x4 o = v[j] * rs * gv;
            u32x2 w; w.x = cvt_pk_bf16(o[0], o[1]); w.y = cvt_pk_bf16(o[2], o[3]); *(u32x2*)(HN + (size_t)r * DM + c) = w; }
    }
}
__device__ __forceinline__ void phase_final(const float* H, const float* part, const float* g, float* out, int bid, int nb) {
    const int wave = tidx() >> 6, lane = tidx() & 63;
    for (int r = bid * 8 + wave; r < SEQ; r += nb * 8) {
        float ss = part[(size_t)(r + 256) * 32 + (lane & 31)];
#pragma unroll
        for (int o = 16; o >= 1; o >>= 1) ss += __shfl_xor(ss, o);
        const float rs = rsqrtf(ss * (1.0f / DM) + EPS); const float* hp = H + (size_t)(r + 256) * DM;
#pragma unroll
        for (int j = 0; j < 8; ++j) { const int c = (j * 64 + lane) * 4; const f32x4 v = *(const f32x4*)(hp + c), gv = *(const f32x4*)(g + c); *(f32x4*)(out + (size_t)r * DM + c) = v * rs * gv; }
    }
}

constexpr int P128 = 272;
constexpr int P256 = 528;
__device__ __forceinline__ void stage_tile(LAS unsigned char* img, int lp, const bf16_t* g, size_t gp, int ncols) {
    const int segs = ncols >> 3, total = 128 * segs;
    for (int i = tidx(); i < total; i += NT) { const int r = i / segs, s = i - r * segs;
        *(LAS u32x4*)(img + r * lp + s * 16) = *(const u32x4*)(g + (size_t)r * gp + s * 8); }
}
__device__ __forceinline__ void stage_tile_kdec(LAS unsigned char* img, int lp, const bf16_t* g, size_t gp, float lg) {
    for (int i = tidx(); i < 128 * 16; i += NT) { const int r = i >> 4, s = i & 15; const float sc = __expf(lg * (float)(127 - r));
        const u32x4 w = *(const u32x4*)(g + (size_t)r * gp + s * 8); f32x4 a, b; unpack8(w, a, b); *(LAS u32x4*)(img + r * lp + s * 16) = pack8(a * sc, b * sc); }
}

__device__ __forceinline__ void gla_gate(const Params& p, unsigned char* ws, int l, int n, int h, LAS float* glrS  , LAS float* segT  , float (&bl)[32], float& blast) {
    const int t = tidx(), d = t & 127, seg = t >> 7;
    const float* GLR = (const float*)(ws + WS_GLR);
    for (int i = t; i < 128 * 16 / 4; i += NT) *(LAS f32x4*)(glrS + i * 4) = *(const f32x4*)(GLR + (size_t)n * 128 * 16 + i * 4);
    float wa[16];
#pragma unroll
    for (int r = 0; r < 16; ++r) wa[r] = p.gla_w_a[((size_t)l * 16 + r) * 512 + h * 128 + d];
    const float ba = p.gla_b_a[(size_t)l * 512 + h * 128 + d];
    __syncthreads();
    float cum = 0.f;
#pragma unroll
    for (int i = 0; i < 32; ++i) { const int s = seg * 32 + i; float x = ba;
#pragma unroll
        for (int r4 = 0; r4 < 4; ++r4) { const f32x4 gv = *(const LAS f32x4*)(glrS + s * 16 + r4 * 4); x += gv[0] * wa[r4 * 4] + gv[1] * wa[r4 * 4 + 1] + gv[2] * wa[r4 * 4 + 2] + gv[3] * wa[r4 * 4 + 3]; }
        float la = logsigmoidf_(x) * (1.0f / 16.0f); if (n * 128 + s < ROW0) la = 0.f;
        cum += la; bl[i] = cum; }
    segT[seg * 128 + d] = cum;
    __syncthreads();
    float pre = 0.f, tot = 0.f;
#pragma unroll
    for (int k = 0; k < 4; ++k) { const float v = segT[k * 128 + d]; tot += v; if (k < seg) pre += v; }
#pragma unroll
    for (int i = 0; i < 32; ++i) bl[i] += pre;
    blast = tot;
}

__device__ __forceinline__ void ret_state_unit(const Params& p, unsigned char* ws, LAS unsigned char* lds, int n, int h) {
    const int t = tidx(), w = t >> 6, lane = t & 63;
    const bf16_t* PJ = (const bf16_t*)(ws + WS_PROJ) + (size_t)n * 128 * PLD;
    LAS unsigned char* Kimg = lds; LAS unsigned char* Vimg = lds + 128 * P128;
    const float lg = ret_log_gamma(h);
    stage_tile_kdec(Kimg, P128, PJ + C_RK + h * 128, PLD, lg);
    stage_tile(Vimg, P128, PJ + C_RV + h * 128, PLD, 128);
    __syncthreads();
    const int d0 = (w >> 1) * 32, v0 = (w & 1) * 64;
    f32x4 acc[2][4];
#pragma unroll
    for (int a = 0; a < 2; ++a)
#pragma unroll
        for (int b = 0; b < 4; ++b) acc[a][b] = (f32x4){0.f, 0.f, 0.f, 0.f};
#pragma unroll
    for (int ks = 0; ks < 4; ++ks) { bf16x8 a[2], b[4];
#pragma unroll
        for (int mi = 0; mi < 2; ++mi) a[mi] = frag_tr(Kimg, P128, 32 * ks, d0 + 16 * mi, lane);
#pragma unroll
        for (int ni = 0; ni < 4; ++ni) b[ni] = frag_tr(Vimg, P128, 32 * ks, v0 + 16 * ni, lane);
#pragma unroll
        for (int mi = 0; mi < 2; ++mi)
#pragma unroll
            for (int ni = 0; ni < 4; ++ni) acc[mi][ni] = MFMA16(a[mi], b[ni], acc[mi][ni]); }
    float* KV = (float*)(ws + WS_RKV) + (size_t)(n * 8 + h) * 128 * 128;
#pragma unroll
    for (int mi = 0; mi < 2; ++mi)
#pragma unroll
        for (int ni = 0; ni < 4; ++ni)
#pragma unroll
            for (int r = 0; r < 4; ++r) KV[(d0 + 16 * mi + 4 * (lane >> 4) + r) * 128 + v0 + 16 * ni + (lane & 15)] = acc[mi][ni][r];
    __syncthreads();
}
__device__ __forceinline__ void gla_state_unit(const Params& p, unsigned char* ws, LAS unsigned char* lds, int l, int n, int h) {
    const int t = tidx(), w = t >> 6, lane = t & 63, d = t & 127, seg = t >> 7;
    const bf16_t* PJ = (const bf16_t*)(ws + WS_PROJ) + (size_t)n * 128 * PLD;
    LAS unsigned char* Kimg = lds; LAS unsigned char* Vimg = lds + 128 * P128;
    LAS float* glrS = (LAS float*)(lds + 128 * P128 + 128 * P256); LAS float* segT = glrS + 128 * 16;
    float bl[32], blast;
    gla_gate(p, ws, l, n, h, glrS, segT, bl, blast);
#pragma unroll
    for (int i = 0; i < 32; ++i) { const int s = seg * 32 + i; const float k = bf2f(PJ[(size_t)s * PLD + C_GK + h * 128 + d]);
        *(LAS bf16_t*)(Kimg + s * P128 + d * 2) = f2bf(k * __expf(blast - bl[i])); }
    if (seg == 0) ((float*)(ws + WS_GDEC))[(size_t)(n * 4 + h) * 128 + d] = __expf(blast);
    stage_tile(Vimg, P256, PJ + C_GV + h * 256, PLD, 256);
    __syncthreads();
    const int d0 = (w >> 2) * 64, v0 = (w & 3) * 64;
    f32x4 acc[4][4];
#pragma unroll
    for (int a = 0; a < 4; ++a)
#pragma unroll
        for (int b = 0; b < 4; ++b) acc[a][b] = (f32x4){0.f, 0.f, 0.f, 0.f};
#pragma unroll
    for (int ks = 0; ks < 4; ++ks) { bf16x8 a[4], b[4];
#pragma unroll
        for (int mi = 0; mi < 4; ++mi) a[mi] = frag_tr(Kimg, P128, 32 * ks, d0 + 16 * mi, lane);
#pragma unroll
        for (int ni = 0; ni < 4; ++ni) b[ni] = frag_tr(Vimg, P256, 32 * ks, v0 + 16 * ni, lane);
#pragma unroll
        for (int mi = 0; mi < 4; ++mi)
#pragma unroll
            for (int ni = 0; ni < 4; ++ni) acc[mi][ni] = MFMA16(a[mi], b[ni], acc[mi][ni]); }
    float* KV = (float*)(ws + WS_GKV) + (size_t)(n * 4 + h) * 128 * 256;
#pragma unroll
    for (int mi = 0; mi < 4; ++mi)
#pragma unroll
        for (int ni = 0; ni < 4; ++ni)
#pragma unroll
            for (int r = 0; r < 4; ++r) KV[(d0 + 16 * mi + 4 * (lane >> 4) + r) * 256 + v0 + 16 * ni + (lane & 15)] = acc[mi][ni][r];
    __syncthreads();
}

__device__ __forceinline__ void s5_disc(const Params& p, int l, int g, int pp, float& ar, float& ai, float& fre, float& fim) {
    const float dt = __expf(p.s5_logdt[l * 64 + g]); const float lr = p.s5_lre[(size_t)(l * 64 + g) * 64 + pp], li = p.s5_lim[(size_t)(l * 64 + g) * 64 + pp];
    const float mag = __expf(lr * dt); float s, c; sincos_red(li * dt, s, c); ar = mag * c; ai = mag * s;
    const float den = lr * lr + li * li, nr = ar - 1.0f, ni = ai; fre = (nr * lr + ni * li) / den; fim = (ni * lr - nr * li) / den;
}
constexpr int S5_BU = 0;
constexpr int S5_U = S5_BU + 128 * 132 * 4;
constexpr int S5_BB = S5_U + 128 * 80;
constexpr int S5_H = S5_BB + 128 * 80;
constexpr int S5_C = S5_H + 128 * P128;
constexpr int S5_SEG = S5_C + 16 * P128;
__device__ __forceinline__ void s5_unit(const Params& p, unsigned char* ws, LAS unsigned char* lds, int l, int n, int g, int mode) {
    const int t = tidx(), w = t >> 6, lane = t & 63;
    const bf16_t* PJ = (const bf16_t*)(ws + WS_PROJ) + (size_t)n * 128 * PLD;
    LAS float* BU = (LAS float*)(lds + S5_BU); LAS unsigned char* Uimg = lds + S5_U; LAS unsigned char* BBimg = lds + S5_BB;
    LAS unsigned char* Himg = lds + S5_H; LAS unsigned char* Cimg = lds + S5_C; LAS float* SEG = (LAS float*)(lds + S5_SEG);
    { const int pp = t >> 3, c2 = (t & 7) * 2; float ar, ai, fre, fim; s5_disc(p, l, g, pp, ar, ai, fre, fim);
        const size_t bo = ((size_t)(l * 64 + g) * 64 + pp) * 16 + c2;
        const float br0 = p.s5_bre[bo], br1 = p.s5_bre[bo + 1], bi0 = p.s5_bim[bo], bi1 = p.s5_bim[bo + 1];
        *(LAS unsigned*)(BBimg + pp * 80 + c2 * 2) = cvt_pk_bf16(fre * br0 - fim * bi0, fre * br1 - fim * bi1);
        *(LAS unsigned*)(BBimg + (64 + pp) * 80 + c2 * 2) = cvt_pk_bf16(fre * bi0 + fim * br0, fre * bi1 + fim * br1); }
    if (t < 256) { const int r = t >> 1, hf = t & 1;
        *(LAS u32x4*)(Uimg + r * 80 + hf * 16) = *(const u32x4*)(PJ + (size_t)r * PLD + C_SU + g * 16 + hf * 8);
        *(LAS u32x4*)(BBimg + r * 80 + 32 + hf * 16) = (u32x4){0u, 0u, 0u, 0u}; }
    else { const int r = (t - 256) >> 1, hf = t & 1; *(LAS u32x4*)(Uimg + r * 80 + 32 + hf * 16) = (u32x4){0u, 0u, 0u, 0u}; }
    if (mode == 1) {
        for (int i = t; i < 16 * 128; i += NT) { const int c = i >> 7, k = i & 127; const size_t co = ((size_t)(l * 64 + g) * 16 + c) * 64 + (k & 63);
            *(LAS bf16_t*)(Cimg + c * P128 + k * 2) = f2bf(k < 64 ? p.s5_cre[co] : -p.s5_cim[co]); } }
    __syncthreads();
    { const bf16x8 a = frag_row(Uimg, 80, 16 * w, 0, lane);
#pragma unroll
        for (int ni = 0; ni < 8; ++ni) { const bf16x8 b = frag_row(BBimg, 80, 16 * ni, 0, lane); f32x4 acc = (f32x4){0.f, 0.f, 0.f, 0.f}; acc = MFMA16(a, b, acc);
#pragma unroll
            for (int r = 0; r < 4; ++r) BU[(16 * w + 4 * (lane >> 4) + r) * 132 + 16 * ni + (lane & 15)] = acc[r]; } }
    __syncthreads();
    float ar, ai, fre, fim; s5_disc(p, l, g, lane, ar, ai, fre, fim);
    float hlr[16], hli[16];
    { float hr = 0.f, hi = 0.f;
#pragma unroll
        for (int i = 0; i < 16; ++i) { const float bur = BU[(16 * w + i) * 132 + lane], bui = BU[(16 * w + i) * 132 + 64 + lane];
            const float nr = ar * hr - ai * hi + bur, ni = ar * hi + ai * hr + bui; hr = nr; hi = ni; hlr[i] = hr; hli[i] = hi; }
        SEG[(w * 64 + lane) * 2] = hr; SEG[(w * 64 + lane) * 2 + 1] = hi; }
    __syncthreads();
    float a16r = ar, a16i = ai;
#pragma unroll
    for (int k = 0; k < 4; ++k) { const float nr = a16r * a16r - a16i * a16i, ni = 2.0f * a16r * a16i; a16r = nr; a16i = ni; }
    float hinr = 0.f, hini = 0.f;
    if (mode == 1) { const float* Hs = (const float*)(ws + WS_S5H) + ((size_t)(n * 64 + g) * 64 + lane) * 2; hinr = Hs[0]; hini = Hs[1]; }
    for (int k = 0; k < w; ++k) { const float sr = SEG[(k * 64 + lane) * 2], si = SEG[(k * 64 + lane) * 2 + 1];
        const float nr = a16r * hinr - a16i * hini + sr, ni = a16r * hini + a16i * hinr + si; hinr = nr; hini = ni; }
    { float pr = ar, pi = ai;
#pragma unroll
        for (int i = 0; i < 16; ++i) { const float fr_ = hlr[i] + pr * hinr - pi * hini, fi_ = hli[i] + pr * hini + pi * hinr;
            if (mode == 1) { *(LAS bf16_t*)(Himg + (16 * w + i) * P128 + lane * 2) = f2bf(fr_); *(LAS bf16_t*)(Himg + (16 * w + i) * P128 + (64 + lane) * 2) = f2bf(fi_); }
            else if (i == 15 && w == 7) { float* E = (float*)(ws + WS_S5E) + ((size_t)(n * 64 + g) * 64 + lane) * 2; E[0] = fr_; E[1] = fi_; }
            const float nr = pr * ar - pi * ai, ni = pr * ai + pi * ar; pr = nr; pi = ni; } }
    __syncthreads();
    if (mode == 1) {
        f32x4 acc = (f32x4){0.f, 0.f, 0.f, 0.f};
#pragma unroll
        for (int ks = 0; ks < 4; ++ks) { const bf16x8 a = frag_row(Himg, P128, 16 * w, 32 * ks, lane), b = frag_row(Cimg, P128, 0, 32 * ks, lane); acc = MFMA16(a, b, acc); }
        const int c = lane & 15; const float dd = p.s5_d[(size_t)l * 1024 + g * 16 + c];
        bf16_t* SP = (bf16_t*)(ws + WS_SOPRE);
#pragma unroll
        for (int r = 0; r < 4; ++r) { const int tt = 16 * w + 4 * (lane >> 4) + r; const float u = bf2f(*(const LAS bf16_t*)(Uimg + tt * 80 + c * 2));
            SP[(size_t)(n * 128 + tt) * 1024 + g * 16 + c] = f2bf(geluf_(acc[r] + dd * u)); }
        __syncthreads();
    }
}

__device__ __forceinline__ void phase_scan(const Params& p, unsigned char* ws, int l, int bid, int nb) {
    const size_t gtid = (size_t)bid * NT + tidx(), gsz = (size_t)nb * NT;
    { const float* KV = (const float*)(ws + WS_RKV); bf16_t* PV = (bf16_t*)(ws + WS_RPREV);
        for (size_t e = gtid; e < (size_t)8 * 16384; e += gsz) { const int h = (int)(e >> 14); const size_t dv = e & 16383; const float g128 = __expf(ret_log_gamma(h) * 128.0f); float prev = 0.f;
#pragma unroll 5
            for (int n = 1; n < NCH; ++n) { const size_t idx = (size_t)(n * 8 + h) * 16384 + dv; const float kv = KV[idx]; PV[idx] = f2bf(prev); prev = g128 * prev + kv; } } }
    { const float* KV = (const float*)(ws + WS_GKV); bf16_t* PV = (bf16_t*)(ws + WS_GPREV); const float* DEC = (const float*)(ws + WS_GDEC);
        for (size_t e = gtid; e < (size_t)4 * 32768; e += gsz) { const int h = (int)(e >> 15); const size_t dv = e & 32767; const int d = (int)(dv >> 8); float prev = 0.f;
#pragma unroll 5
            for (int n = 1; n < NCH; ++n) { const size_t idx = (size_t)(n * 4 + h) * 32768 + dv; const float kv = KV[idx]; const float dc = DEC[(size_t)(n * 4 + h) * 128 + d]; PV[idx] = f2bf(prev); prev = dc * prev + kv; } } }
    { const float* E = (const float*)(ws + WS_S5E); float* Hs = (float*)(ws + WS_S5H);
        for (size_t e = gtid; e < (size_t)4096; e += gsz) { const int g = (int)(e >> 6), pp = (int)(e & 63); float ar, ai, fre, fim; s5_disc(p, l, g, pp, ar, ai, fre, fim);
#pragma unroll
            for (int k = 0; k < 7; ++k) { const float nr = ar * ar - ai * ai, ni = 2.0f * ar * ai; ar = nr; ai = ni; }
            float hr = 0.f, hi = 0.f;
#pragma unroll 5
            for (int n = 1; n < NCH; ++n) { const size_t idx = ((size_t)n * 4096 + e) * 2; const float er = E[idx], ei = E[idx + 1]; Hs[idx] = hr; Hs[idx + 1] = hi;
                const float nr = ar * hr - ai * hi + er, ni = ar * hi + ai * hr + ei; hr = nr; hi = ni; } } }
}

constexpr int OFF_Q = 0, OFF_KS = 128 * P128, OFF_V = 2 * 128 * P128, OFF_P = 3 * 128 * P128, OFF_X = 4 * 128 * P128;
__device__ __forceinline__ void ret_out_unit(const Params& p, unsigned char* ws, LAS unsigned char* lds, int l, int n, int h) {
    const int t = tidx(), w = t >> 6, lane = t & 63, g4 = lane >> 4, l15 = lane & 15;
    const bf16_t* PJ = (const bf16_t*)(ws + WS_PROJ) + (size_t)n * 128 * PLD;
    LAS unsigned char* Qimg = lds + OFF_Q; LAS unsigned char* KSimg = lds + OFF_KS; LAS unsigned char* Vimg = lds + OFF_V; LAS unsigned char* Pimg = lds + OFF_P;
    LAS float* RED = (LAS float*)(lds + OFF_X);
    const float lg = ret_log_gamma(h);
    stage_tile(Qimg, P128, PJ + C_RQ + h * 128, PLD, 128);
    stage_tile(KSimg, P128, PJ + C_RK + h * 128, PLD, 128);
    stage_tile(Vimg, P128, PJ + C_RV + h * 128, PLD, 128);
    stage_tile(Pimg, P128, (const bf16_t*)(ws + WS_RPREV) + (size_t)(n * 8 + h) * 16384, 128, 128);
    __syncthreads();
    const int c0 = (w >> 1) * 32, x0 = (w & 1) * 64;
    f32x4 sc[2][4];
#pragma unroll
    for (int a = 0; a < 2; ++a)
#pragma unroll
        for (int b = 0; b < 4; ++b) sc[a][b] = (f32x4){0.f, 0.f, 0.f, 0.f};
    if (x0 <= c0 + 31) {
#pragma unroll
        for (int ks = 0; ks < 4; ++ks) { bf16x8 a[2], b[4];
#pragma unroll
            for (int mi = 0; mi < 2; ++mi) a[mi] = frag_row(Qimg, P128, c0 + 16 * mi, 32 * ks, lane);
#pragma unroll
            for (int ni = 0; ni < 4; ++ni) b[ni] = frag_row(KSimg, P128, x0 + 16 * ni, 32 * ks, lane);
#pragma unroll
            for (int mi = 0; mi < 2; ++mi)
#pragma unroll
                for (int ni = 0; ni < 4; ++ni) sc[mi][ni] = MFMA16(a[mi], b[ni], sc[mi][ni]); } }
    __syncthreads();
#pragma unroll
    for (int mi = 0; mi < 2; ++mi)
#pragma unroll
        for (int ni = 0; ni < 4; ++ni)
#pragma unroll
            for (int r = 0; r < 4; ++r) { const int c = c0 + 16 * mi + 4 * g4 + r, s = x0 + 16 * ni + l15;
                const float v = (c >= s) ? sc[mi][ni][r] * __expf(lg * (float)(c - s)) : 0.f; *(LAS bf16_t*)(KSimg + c * P128 + s * 2) = f2bf(v); }
    __syncthreads();
    f32x4 a1[2][4], a2[2][4];
#pragma unroll
    for (int a = 0; a < 2; ++a)
#pragma unroll
        for (int b = 0; b < 4; ++b) { a1[a][b] = (f32x4){0.f, 0.f, 0.f, 0.f}; a2[a][b] = (f32x4){0.f, 0.f, 0.f, 0.f}; }
#pragma unroll
    for (int ks = 0; ks < 4; ++ks) { bf16x8 sa[2], qa[2], vb[4], pb[4];
#pragma unroll
        for (int mi = 0; mi < 2; ++mi) { sa[mi] = frag_row(KSimg, P128, c0 + 16 * mi, 32 * ks, lane); qa[mi] = frag_row(Qimg, P128, c0 + 16 * mi, 32 * ks, lane); }
#pragma unroll
        for (int ni = 0; ni < 4; ++ni) { vb[ni] = frag_tr(Vimg, P128, 32 * ks, x0 + 16 * ni, lane); pb[ni] = frag_tr(Pimg, P128, 32 * ks, x0 + 16 * ni, lane); }
#pragma unroll
        for (int mi = 0; mi < 2; ++mi)
#pragma unroll
            for (int ni = 0; ni < 4; ++ni) { a1[mi][ni] = MFMA16(sa[mi], vb[ni], a1[mi][ni]); a2[mi][ni] = MFMA16(qa[mi], pb[ni], a2[mi][ni]); } }
#pragma unroll
    for (int mi = 0; mi < 2; ++mi)
#pragma unroll
        for (int r = 0; r < 4; ++r) { const int c = c0 + 16 * mi + 4 * g4 + r; const float qd = __expf(lg * (float)(c + 1)); float s = 0.f, ss = 0.f;
#pragma unroll
            for (int ni = 0; ni < 4; ++ni) { const float o = a1[mi][ni][r] + qd * a2[mi][ni][r]; a1[mi][ni][r] = o; s += o; ss += o * o; }
#pragma unroll
            for (int o = 1; o <= 8; o <<= 1) { s += __shfl_xor(s, o); ss += __shfl_xor(ss, o); }
            if (l15 == 0) { RED[(c * 2 + (w & 1)) * 2] = s; RED[(c * 2 + (w & 1)) * 2 + 1] = ss; } }
    __syncthreads();
    bf16_t* RO = (bf16_t*)(ws + WS_RO);
#pragma unroll
    for (int mi = 0; mi < 2; ++mi)
#pragma unroll
        for (int r = 0; r < 4; ++r) { const int c = c0 + 16 * mi + 4 * g4 + r; const float s = RED[c * 4] + RED[c * 4 + 2], ss = RED[c * 4 + 1] + RED[c * 4 + 3];
            const float mu = s * (1.0f / 128.0f); const float var = fmaxf(ss * (1.0f / 128.0f) - mu * mu, 0.f); const float rstd = rsqrtf(var + EPS);
            const size_t row = (size_t)n * 128 + c;
#pragma unroll
            for (int ni = 0; ni < 4; ++ni) { const int v = x0 + 16 * ni + l15; const float gn = p.ret_norm_g[(size_t)l * 1024 + h * 128 + v];
                const float gate = bf2f(PJ[(size_t)c * PLD + C_RG + h * 128 + v]);
                RO[row * 1024 + h * 128 + v] = f2bf((a1[mi][ni][r] - mu) * rstd * gn * gate); } }
    __syncthreads();
}
__device__ __forceinline__ void gla_out_unit(const Params& p, unsigned char* ws, LAS unsigned char* lds, int l, int n, int h) {
    const int t = tidx(), w = t >> 6, lane = t & 63, g4 = lane >> 4, l15 = lane & 15, d = t & 127, seg = t >> 7;
    const bf16_t* PJ = (const bf16_t*)(ws + WS_PROJ) + (size_t)n * 128 * PLD;
    LAS unsigned char* Qimg = lds + OFF_Q; LAS unsigned char* KSimg = lds + OFF_KS; LAS unsigned char* Vimg = lds + OFF_V; LAS unsigned char* Pimg = lds + OFF_P;
    LAS float* glrS = (LAS float*)(lds + OFF_X); LAS float* segT = glrS + 128 * 16; LAS float* RED = segT + 4 * 128;
    const bf16_t* PV = (const bf16_t*)(ws + WS_GPREV) + (size_t)(n * 4 + h) * 32768;
    { float bl[32], blast; gla_gate(p, ws, l, n, h, glrS, segT, bl, blast);
#pragma unroll
        for (int i = 0; i < 32; ++i) { const int s = seg * 32 + i; const float q = bf2f(PJ[(size_t)s * PLD + C_GQ + h * 128 + d]), k = bf2f(PJ[(size_t)s * PLD + C_GK + h * 128 + d]);
            *(LAS bf16_t*)(Qimg + s * P128 + d * 2) = f2bf(q * __expf(bl[i])); *(LAS bf16_t*)(KSimg + s * P128 + d * 2) = f2bf(k * __expf(-bl[i])); } }
    stage_tile(Vimg, P128, PJ + C_GV + h * 256, PLD, 128);
    stage_tile(Pimg, P128, PV, 256, 128);
    __syncthreads();
    const int c0 = (w >> 1) * 32, x0 = (w & 1) * 64;
    f32x4 sc[2][4];
#pragma unroll
    for (int a = 0; a < 2; ++a)
#pragma unroll
        for (int b = 0; b < 4; ++b) sc[a][b] = (f32x4){0.f, 0.f, 0.f, 0.f};
    if (x0 <= c0 + 31) {
#pragma unroll
        for (int ks = 0; ks < 4; ++ks) { bf16x8 a[2], b[4];
#pragma unroll
            for (int mi = 0; mi < 2; ++mi) a[mi] = frag_row(Qimg, P128, c0 + 16 * mi, 32 * ks, lane);
#pragma unroll
            for (int ni = 0; ni < 4; ++ni) b[ni] = frag_row(KSimg, P128, x0 + 16 * ni, 32 * ks, lane);
#pragma unroll
            for (int mi = 0; mi < 2; ++mi)
#pragma unroll
                for (int ni = 0; ni < 4; ++ni) sc[mi][ni] = MFMA16(a[mi], b[ni], sc[mi][ni]); } }
    __syncthreads();
#pragma unroll
    for (int mi = 0; mi < 2; ++mi)
#pragma unroll
        for (int ni = 0; ni < 4; ++ni)
#pragma unroll
            for (int r = 0; r < 4; ++r) { const int c = c0 + 16 * mi + 4 * g4 + r, s = x0 + 16 * ni + l15;
                const float v = (c >= s) ? sc[mi][ni][r] : 0.f; *(LAS bf16_t*)(KSimg + c * P128 + s * 2) = f2bf(v); }
    __syncthreads();
    f32x4 oa[2][2][4];
#pragma unroll
    for (int hf = 0; hf < 2; ++hf) {
        if (hf == 1) { __syncthreads(); stage_tile(Vimg, P128, PJ + C_GV + h * 256 + 128, PLD, 128); stage_tile(Pimg, P128, PV + 128, 256, 128); __syncthreads(); }
#pragma unroll
        for (int a = 0; a < 2; ++a)
#pragma unroll
            for (int b = 0; b < 4; ++b) oa[hf][a][b] = (f32x4){0.f, 0.f, 0.f, 0.f};
#pragma unroll
        for (int ks = 0; ks < 4; ++ks) { bf16x8 sa[2], qa[2], vb[4], pb[4];
#pragma unroll
            for (int mi = 0; mi < 2; ++mi) { sa[mi] = frag_row(KSimg, P128, c0 + 16 * mi, 32 * ks, lane); qa[mi] = frag_row(Qimg, P128, c0 + 16 * mi, 32 * ks, lane); }
#pragma unroll
            for (int ni = 0; ni < 4; ++ni) { vb[ni] = frag_tr(Vimg, P128, 32 * ks, x0 + 16 * ni, lane); pb[ni] = frag_tr(Pimg, P128, 32 * ks, x0 + 16 * ni, lane); }
#pragma unroll
            for (int mi = 0; mi < 2; ++mi)
#pragma unroll
                for (int ni = 0; ni < 4; ++ni) { oa[hf][mi][ni] = MFMA16(sa[mi], vb[ni], oa[hf][mi][ni]); oa[hf][mi][ni] = MFMA16(qa[mi], pb[ni], oa[hf][mi][ni]); } }
    }
#pragma unroll
    for (int mi = 0; mi < 2; ++mi)
#pragma unroll
        for (int r = 0; r < 4; ++r) { const int c = c0 + 16 * mi + 4 * g4 + r; float ss = 0.f;
#pragma unroll
            for (int hf = 0; hf < 2; ++hf)
#pragma unroll
                for (int ni = 0; ni < 4; ++ni) { const float o = oa[hf][mi][ni][r]; ss += o * o; }
#pragma unroll
            for (int o = 1; o <= 8; o <<= 1) ss += __shfl_xor(ss, o);
            if (l15 == 0) RED[c * 2 + (w & 1)] = ss; }
    __syncthreads();
    bf16_t* GO = (bf16_t*)(ws + WS_GO);
#pragma unroll
    for (int mi = 0; mi < 2; ++mi)
#pragma unroll
        for (int r = 0; r < 4; ++r) { const int c = c0 + 16 * mi + 4 * g4 + r; const float ss = RED[c * 2] + RED[c * 2 + 1]; const float rstd = rsqrtf(ss * (1.0f / 256.0f) + EPS);
            const size_t row = (size_t)n * 128 + c;
#pragma unroll
            for (int hf = 0; hf < 2; ++hf)
#pragma unroll
                for (int ni = 0; ni < 4; ++ni) { const int v = hf * 128 + x0 + 16 * ni + l15; const float gn = p.gla_norm_g[(size_t)l * 256 + v];
                    const float gate = bf2f(PJ[(size_t)c * PLD + C_GG + h * 256 + v]);
                    GO[row * 1024 + h * 256 + v] = f2bf(oa[hf][mi][ni][r] * rstd * gn * gate); } }
    __syncthreads();
}

constexpr int U_GLA = 65 * 4, U_RET = 65 * 8, U_S5 = 65 * 64, U_ALL = U_GLA + U_RET + U_S5;
__device__ __forceinline__ void phase_states(const Params& p, unsigned char* ws, LAS unsigned char* lds, int l, int bid, int nb) {
    for (int u = bid; u < U_ALL; u += nb) {
        if (u < U_GLA) gla_state_unit(p, ws, lds, l, 1 + u / 4, u % 4);
        else if (u < U_GLA + U_RET) { const int v = u - U_GLA; ret_state_unit(p, ws, lds, 1 + v / 8, v % 8); }
        else { const int v = u - U_GLA - U_RET; s5_unit(p, ws, lds, l, 1 + v / 64, v % 64, 0); }
    }
}
__device__ __forceinline__ void phase_outputs(const Params& p, unsigned char* ws, LAS unsigned char* lds, int l, int bid, int nb) {
    for (int u = bid; u < U_ALL; u += nb) {
        if (u < U_GLA) gla_out_unit(p, ws, lds, l, 1 + u / 4, u % 4);
        else if (u < U_GLA + U_RET) { const int v = u - U_GLA; ret_out_unit(p, ws, lds, l, 1 + v / 8, v % 8); }
        else { const int v = u - U_GLA - U_RET; s5_unit(p, ws, lds, l, 1 + v / 64, v % 64, 1); }
    }
}

__global__ void __launch_bounds__(NT) mega(Params p) {
    extern __shared__ __attribute__((aligned(16))) unsigned char lds_raw[];
    LAS unsigned char* lds = (LAS unsigned char*)lds_raw;
    cg::grid_group grid = cg::this_grid();
    const int bid = blockIdx.x, nb = gridDim.x;
    unsigned char* const p_ws0 = p.ws; unsigned char* ws = p_ws0;
#define FRESH() do { int z_ = 0; asm volatile("" : "+v"(z_)); ws = p_ws0 + __builtin_amdgcn_readfirstlane(z_); } while (0)
#define WSP(T, off) ((T*)(ws + (off)))

    volatile LAS unsigned* st = (volatile LAS unsigned*)(lds + LDS_BYTES - 16);
    if (tidx() == 0) { st[0] = 0u; st[1] = 0u; }
    __syncthreads();
    (void)xcd_barrier_post((unsigned*)(p_ws0 + WS_BAR), st);
#define GSYNC() do { XcdBarrier b_; b_.bar = (unsigned*)(p.ws + WS_BAR); b_.x = xb_xcc_id(); b_.st = (volatile LAS unsigned*)(lds + LDS_BYTES - 16); xcd_barrier(b_); } while (0)
    FRESH(); phase_prep(p, ws, lds, bid, nb);
    grid.sync();
    for (int l = 0; l < DEPTH; ++l) {
        FRESH();
        { const bf16_t* HN = WSP(const bf16_t, WS_HN); const bf16_t* W = WSP(const bf16_t, WS_WIN) + (size_t)l * NIN_T * DM;
            pg8::Gemm g{HN, W, 0, 0, MR, NIN_T, DM}; pg8::StaticOrder S; S.init(MR, NIN_T, nb, bid, 1);
            EpiIn E{WSP(bf16_t, WS_PROJ), WSP(float, WS_GLR), WSP(const float, WS_COS), WSP(const float, WS_SIN), WSP(const float, WS_SS) + (size_t)l * MR * 32};
            pg8::gemm_phase<EpiIn>(lds, g, S, E); }
        GSYNC();
        FRESH(); phase_states(p, ws, lds, l, bid, nb);
        GSYNC();
        FRESH(); phase_scan(p, ws, l, bid, nb);
        GSYNC();
        FRESH(); phase_outputs(p, ws, lds, l, bid, nb);
        GSYNC();
        FRESH();
        { const bf16_t* A = WSP(const bf16_t, WS_SOPRE); const bf16_t* W = WSP(const bf16_t, WS_WGLU) + (size_t)l * 1024 * 1024;
            pg8::Gemm g{A, W, 0, 0, MR, 1024, 1024}; pg8::StaticOrder S; S.init(MR, 1024, nb, bid, 1);
            EpiGlu E{A, WSP(const bf16_t, WS_PROJ), WSP(bf16_t, WS_SO)};
            pg8::gemm_phase<EpiGlu>(lds, g, S, E); }
        GSYNC();
        FRESH();
        { const bf16_t* W = WSP(const bf16_t, WS_WBR) + (size_t)l * 3 * 2048 * 1024;
            pg8::Gemm g{WSP(const bf16_t, WS_RO), W, WS_GO - WS_RO, (size_t)2048 * 1024 * 2, MR, 2048, 1024};
            static_assert(WS_SO - WS_GO == WS_GO - WS_RO, "branch inputs must be equally spaced");
            pg8::StaticOrder S; S.init(MR, 2048, nb, bid, 3);
            EpiBr E{WSP(const bf16_t, WS_PROJ), WSP(float, WS_YACC), WSP(bf16_t, WS_Y)};
            pg8::gemm_phase<EpiBr>(lds, g, S, E); }
        GSYNC();
        FRESH();
        { const bf16_t* A = WSP(const bf16_t, WS_Y); const bf16_t* W = WSP(const bf16_t, WS_WOUT) + (size_t)l * 2048 * 2048;
            pg8::Gemm g{A, W, 0, 0, MR, 2048, 2048}; pg8::StaticOrder S; S.init(MR, 2048, nb, bid, 1);
            EpiOut E{WSP(float, WS_H), WSP(bf16_t, WS_HN), l + 1 < DEPTH ? p.norm_g + (size_t)(l + 1) * DM : (const float*)nullptr, WSP(float, WS_SS) + (size_t)(l + 1) * MR * 32};
            pg8::gemm_phase<EpiOut>(lds, g, S, E); }
        GSYNC();
    }
    FRESH(); phase_final(WSP(const float, WS_H), WSP(const float, WS_SS) + (size_t)DEPTH * MR * 32, p.final_g, p.out, bid, nb);
}

extern "C" void kernel_launch(void* const* d_in, const int* in_sizes, int n_in, void* d_out, int out_size, void* d_ws, size_t ws_size, hipStream_t stream) {
    static int grid = 0;
    if (grid == 0) {
        if (n_in != 22 || ws_size < WS_END) { fprintf(stderr, "kernel_launch: unexpected inputs (n_in %d) or workspace too small (%zu < %zu)\n", n_in, ws_size, (size_t)WS_END); grid = -1; return; }
        int dev = 0, cus = 0, per_cu = 0;
        hipGetDevice(&dev); hipDeviceGetAttribute(&cus, hipDeviceAttributeMultiprocessorCount, dev);
        if (hipFuncSetAttribute((const void*)mega, hipFuncAttributeMaxDynamicSharedMemorySize, LDS_BYTES) != hipSuccess) { fprintf(stderr, "kernel_launch: hipFuncSetAttribute failed\n"); grid = -1; return; }
        if (hipOccupancyMaxActiveBlocksPerMultiprocessor(&per_cu, (const void*)mega, NT, LDS_BYTES) != hipSuccess || per_cu < 1) { fprintf(stderr, "kernel_launch: occupancy query gave %d\n", per_cu); per_cu = 1; (void)hipGetLastError(); }
        grid = cus * per_cu;
    }
    if (grid < 0) return;
    Params p{};
    const float** f = (const float**)&p;
    for (int i = 0; i < 22; ++i) f[i] = (const float*)d_in[i];
    p.out = (float*)d_out; p.ws = (unsigned char*)d_ws;
    if (hipMemsetAsync((char*)d_ws + WS_BAR, 0, 3456 * 4, stream) != hipSuccess) { fprintf(stderr, "kernel_launch: memset failed\n"); return; }
    void* args[] = {&p};
    hipError_t e = hipLaunchCooperativeKernel((const void*)mega, dim3(grid), dim3(NT), args, LDS_BYTES, stream);
    if (e != hipSuccess) fprintf(stderr, "cooperative launch failed: %s (grid %d)\n", hipGetErrorString(e), grid);
}
```

```cpp
#include <hip/hip_runtime.h>
#include <hip/hip_cooperative_groups.h>
#include <cstdio>
#include <cstddef>
namespace cg = cooperative_groups;

#ifndef TK
#define TK 0
#endif
#ifndef TK0
#define TK0 0
#endif
#define LAS __attribute__((address_space(3)))
typedef unsigned short bf16_t;
typedef short bf16x8 __attribute__((ext_vector_type(8)));
typedef short s16x4 __attribute__((ext_vector_type(4)));
typedef float f32x4 __attribute__((ext_vector_type(4)));
typedef unsigned u32x4 __attribute__((ext_vector_type(4)));
typedef unsigned u32x2 __attribute__((ext_vector_type(2)));

constexpr int DM = 2048, SEQ = 8192, DEPTH = 4;
constexpr int ROW0 = 240;
constexpr int MR = 8448;
constexpr int NCH = 66;
constexpr int NIN_SRC = 15376;
constexpr int NIN_T = 15616;
constexpr int PLD = 15360;
constexpr int C_RQ = 0, C_RK = 1024, C_RV = 2048, C_RG = 3072, C_GQ = 4096, C_GK = 4608, C_GV = 5120, C_GG = 6144, C_SU = 7168, C_SG = 8192, C_MG = 9216;
constexpr float EPS = 1e-6f;
constexpr int NT = 512;
constexpr int LDS_BYTES = 155648;

constexpr size_t al256(size_t x) { return (x + 255) & ~(size_t)255; }
constexpr size_t WS_H = 0;
constexpr size_t WS_HN = WS_H + al256((size_t)MR * DM * 4);
constexpr size_t WS_PROJ = WS_HN + al256((size_t)MR * DM * 2);
constexpr size_t WS_GLR = WS_PROJ + al256((size_t)MR * PLD * 2);
constexpr size_t WS_WIN = WS_GLR + al256((size_t)MR * 16 * 4);
constexpr size_t WS_WGLU = WS_WIN + al256((size_t)DEPTH * NIN_T * DM * 2);
constexpr size_t WS_WBR = WS_WGLU + al256((size_t)DEPTH * 1024 * 1024 * 2);
constexpr size_t WS_WOUT = WS_WBR + al256((size_t)DEPTH * 3 * 2048 * 1024 * 2);
constexpr size_t WS_COS = WS_WOUT + al256((size_t)DEPTH * 2048 * 2048 * 2);
constexpr size_t WS_SIN = WS_COS + al256((size_t)MR * 64 * 4);
constexpr size_t WS_RKV = WS_SIN + al256((size_t)MR * 64 * 4);
constexpr size_t WS_RPREV = WS_RKV + al256((size_t)NCH * 8 * 128 * 128 * 4);
constexpr size_t WS_GKV = WS_RPREV + al256((size_t)NCH * 8 * 128 * 128 * 2);
constexpr size_t WS_GPREV = WS_GKV + al256((size_t)NCH * 4 * 128 * 256 * 4);
constexpr size_t WS_GDEC = WS_GPREV + al256((size_t)NCH * 4 * 128 * 256 * 2);
constexpr size_t WS_S5E = WS_GDEC + al256((size_t)NCH * 4 * 128 * 4);
constexpr size_t WS_S5H = WS_S5E + al256((size_t)NCH * 64 * 64 * 2 * 4);
constexpr size_t WS_RO = WS_S5H + al256((size_t)NCH * 64 * 64 * 2 * 4);
constexpr size_t WS_GO = WS_RO + al256((size_t)MR * 1024 * 2);
constexpr size_t WS_SO = WS_GO + al256((size_t)MR * 1024 * 2);
constexpr size_t WS_SOPRE = WS_SO + al256((size_t)MR * 1024 * 2);
constexpr size_t WS_Y = WS_SOPRE + al256((size_t)MR * 1024 * 2);
constexpr size_t WS_YACC = WS_Y + al256((size_t)MR * DM * 2);
constexpr size_t WS_SS = WS_YACC + al256((size_t)MR * DM * 4);
constexpr size_t WS_BAR = WS_SS + al256((size_t)(DEPTH + 1) * MR * 64 * 4);
constexpr size_t WS_QCTR = WS_BAR + 3456 * 4;
constexpr size_t WS_STAMP = WS_QCTR + 2 * DEPTH * 256;
constexpr size_t WS_END = WS_STAMP + 512;

struct Params {
    const float* x; const float* meta; const float* norm_g; const float* w_in; const float* ret_norm_g;
    const float* gla_w_a; const float* gla_b_a; const float* gla_norm_g;
    const float* s5_lre; const float* s5_lim; const float* s5_logdt; const float* s5_bre; const float* s5_bim; const float* s5_cre; const float* s5_cim;
    const float* s5_d; const float* s5_wglu; const float* w_br_ret; const float* w_br_gla; const float* w_br_s5; const float* w_out; const float* final_g;
    float* out; unsigned char* ws;
};

typedef const __attribute__((address_space(4))) char* KA;
#define PF(f) (*(decltype(Params::f) const __attribute__((address_space(4)))*)(ka + offsetof(Params, f)))

__device__ __forceinline__ unsigned cvt_pk_bf16(float lo, float hi) { unsigned r; asm("v_cvt_pk_bf16_f32 %0, %1, %2" : "=v"(r) : "v"(lo), "v"(hi)); return r; }
__device__ __forceinline__ bf16_t f2bf(float f) { return (bf16_t)(cvt_pk_bf16(f, 0.f) & 0xffffu); }
__device__ __forceinline__ float bf2f(bf16_t b) { return __uint_as_float(((unsigned)b) << 16); }
__device__ __forceinline__ float bflo(unsigned w) { return __uint_as_float(w << 16); }
__device__ __forceinline__ float bfhi(unsigned w) { return __uint_as_float(w & 0xffff0000u); }
__device__ __forceinline__ float sigmoidf_(float x) { return __builtin_amdgcn_rcpf(1.0f + __expf(-x)); }
__device__ __forceinline__ float siluf_(float x) { return x * __builtin_amdgcn_rcpf(1.0f + __expf(-x)); }
__device__ __forceinline__ float logsigmoidf_(float x) { return fminf(x, 0.f) - __logf(1.0f + __expf(-fabsf(x))); }
__device__ __forceinline__ float geluf_(float x) { const float z = 0.7978845608028654f * (x + 0.044715f * x * x * x); const float t = 1.0f - 2.0f / (__expf(2.0f * z) + 1.0f); return 0.5f * x * (1.0f + t); }
__device__ __forceinline__ void sincos_red(float ang, float& s, float& c) {
    const float n = rintf(ang * 0.15915494309189535f);
    float r = fmaf(-n, 6.2831854820251465f, ang);
    r = fmaf(-n, -1.7484556000744883e-7f, r);
    const float rev = r * 0.15915494309189535f;
    s = __builtin_amdgcn_sinf(rev); c = __builtin_amdgcn_cosf(rev);
}
__device__ __forceinline__ float ret_log_gamma(int h) { return log1pf(-exp2f(-5.0f - (float)h)); }

__device__ __forceinline__ bf16x8 frag_row(const LAS unsigned char* img, int pitch, int r0, int k0, int lane) {
    return *(const LAS bf16x8*)(img + (r0 + (lane & 15)) * pitch + (k0 + 8 * (lane >> 4)) * 2);
}
__device__ __forceinline__ bf16x8 frag_tr(const LAS unsigned char* img, int pitch, int k0, int c0, int lane) {
    const int g = lane >> 4, q = (lane & 15) >> 2, p = lane & 3;
    const LAS unsigned char* a = img + (k0 + 8 * g + q) * pitch + (c0 + 4 * p) * 2;
    const s16x4 lo = __builtin_amdgcn_ds_read_tr16_b64_v4i16((LAS s16x4*)a);
    const s16x4 hi = __builtin_amdgcn_ds_read_tr16_b64_v4i16((LAS s16x4*)(a + 4 * pitch));
    bf16x8 r; r[0] = lo[0]; r[1] = lo[1]; r[2] = lo[2]; r[3] = lo[3]; r[4] = hi[0]; r[5] = hi[1]; r[6] = hi[2]; r[7] = hi[3]; return r;
}
__device__ __forceinline__ int tidx() { int t = (int)__builtin_amdgcn_workitem_id_x(); asm volatile("" : "+v"(t)); return t; }
#define MFMA16(a, b, c) __builtin_amdgcn_mfma_f32_16x16x32_bf16((a), (b), (c), 0, 0, 0)


#define XB_TMO      128
#define XB_XCNT(j)  (256  + 64 * (j))
#define XB_XSUB(j)  (1280 + 64 * (j))
#define XB_XGEN(j)  (2304 + 64 * (j))
#define XB_TOP      3328
#define XB_TOPGEN   3392
#define XCD_BAR_WORDS 3456
#define XB_SPIN_CAP (1u << 22)
__device__ __forceinline__ unsigned xb_ld(unsigned* p)              { return __hip_atomic_load(p, __ATOMIC_RELAXED, __HIP_MEMORY_SCOPE_AGENT); }
__device__ __forceinline__ unsigned xb_add(unsigned* p, unsigned v) { return __hip_atomic_fetch_add(p, v, __ATOMIC_RELAXED, __HIP_MEMORY_SCOPE_AGENT); }
__device__ __forceinline__ unsigned xb_xcc_id() { return (unsigned)__builtin_amdgcn_s_getreg((3 << 11) | 20) & 0xFu; }
#define XB_SPIN(cond, bar) do { unsigned _sp = 0; while (cond) { __builtin_amdgcn_s_sleep(1); \
    if ((++_sp & 255u) == 0u) { if (xb_ld(&(bar)[XB_TMO])) break; if (_sp > XB_SPIN_CAP) { atomicAdd(&(bar)[XB_TMO], 1u); break; } } } } while (0)
struct XcdBarrier { unsigned* bar; unsigned x; volatile LAS unsigned* st; };
__device__ __forceinline__ XcdBarrier xcd_barrier_post(unsigned* bar, volatile LAS unsigned* st) {
    XcdBarrier b; b.bar = bar; b.x = xb_xcc_id(); b.st = st;
    if (tidx() == 0) (void)xb_add(&bar[XB_XCNT(b.x)], 1u);
    return b;
}
__device__ __forceinline__ void xcd_barrier_complete(unsigned* bar, unsigned x, unsigned& nloc, unsigned& nx) {
    const unsigned G = gridDim.x * gridDim.y * gridDim.z;
    unsigned sum, cnt, mine, sp = 0u;
    for (;;) {
        sum = 0u; cnt = 0u; mine = 0u;
#pragma unroll
        for (unsigned j = 0; j < 16; ++j) { const unsigned c = xb_ld(&bar[XB_XCNT(j)]); sum += c; cnt += (c > 0u) ? 1u : 0u; mine = (j == x) ? c : mine; }
        if (sum == G) break;
        __builtin_amdgcn_s_sleep(1);
        if ((++sp & 255u) == 0u) { if (xb_ld(&bar[XB_TMO])) break; if (sp > XB_SPIN_CAP) { atomicAdd(&bar[XB_TMO], 1u); break; } }
    }
    nloc = mine > 0u ? mine : 1u; nx = cnt > 0u ? cnt : 1u;
}
__device__ __forceinline__ void xcd_barrier(const XcdBarrier& b) {
    asm volatile("s_waitcnt vmcnt(0)" ::: "memory");
    __syncthreads();
    if (tidx() == 0) {
        unsigned* bar = b.bar;
        __builtin_amdgcn_s_waitcnt(0);
        unsigned nloc = b.st[0], nx = b.st[1];
        if (nloc == 0u) { xcd_barrier_complete(bar, b.x, nloc, nx); b.st[0] = nloc; b.st[1] = nx; }
        const unsigned old = xb_add(&bar[XB_XSUB(b.x)], 1u);
        const unsigned gen = old / nloc;
        if (old + 1u == (gen + 1u) * nloc) {
            __builtin_amdgcn_fence(__ATOMIC_RELEASE, "agent");
            asm volatile("s_waitcnt vmcnt(0)" ::: "memory");
            const unsigned og = xb_add(&bar[XB_TOP], 1u);
            const unsigned tg = og / nx;
            if (og + 1u == (tg + 1u) * nx) xb_add(&bar[XB_TOPGEN], 1u);
            else XB_SPIN(xb_ld(&bar[XB_TOPGEN]) == tg, bar);
            __builtin_amdgcn_fence(__ATOMIC_ACQUIRE, "agent");
            xb_add(&bar[XB_XGEN(b.x)], 1u);
            asm volatile("s_waitcnt vmcnt(0)" ::: "memory");
        } else {
            XB_SPIN(xb_ld(&bar[XB_XGEN(b.x)]) == gen, bar);
            __builtin_amdgcn_fence(__ATOMIC_ACQUIRE, "agent");
            asm volatile("s_waitcnt vmcnt(0)" ::: "memory");
        }
    }
    __syncthreads();
}

namespace pg8 {
constexpr int BM = 256, BK = 64, HALF = 128, HTB = HALF * BK * 2, STAGE_BYTES = 8 * HTB, NXCD = 8, WGM = 8;
__host__ __device__ __forceinline__ int lds_byte(int r, int c) { const int st = (r >> 4) * 2 + (c >> 5), rr = r & 15, cc = c & 31, ob = rr * 64 + cc * 2; return st * 1024 + (ob ^ (((ob >> 9) & 1) << 5)); }
__host__ __device__ __forceinline__ void stage_rc(int b, int& R, int& C) { const int st = b / 1024, sb = b % 1024, swz = sb ^ (((sb >> 9) & 1) << 5); R = (st >> 1) * 16 + swz / 64; C = (st & 1) * 32 + (swz % 64) / 2; }
__host__ __device__ __forceinline__ int perm32(int rho) { const int n = rho >> 4, i = rho & 15; return 8 * (i >> 2) + 4 * n + (i & 3); }

struct Unit { int pm, pn, sel; };
struct Gemm { const bf16_t* A; const bf16_t* Bt; size_t selA, selB; int M, N, K; };
__device__ __forceinline__ const char* selA(const Gemm& g, int s) { return (const char*)g.A + (size_t)s * g.selA; }
__device__ __forceinline__ const char* selB(const Gemm& g, int s) { return (const char*)g.Bt + (size_t)s * g.selB; }

struct StaticOrder {
    int nM, nN, nwg, G, c, nsel, pm0;
    __device__ void init(int M, int N, int G_, int c_, int nsel_, int pm0_ = 0) { nM = M / BM; nN = N / BM; nwg = nM * nN; G = G_; c = c_; nsel = nsel_; pm0 = pm0_; }
    __device__ bool next(int i, Unit& u) const {
        const int it = i / nsel; u.sel = i - it * nsel;
        const long L = (long)it * G + c; if (L >= nwg) return false;
        int wgid = (int)L; { const int q = nwg / NXCD, r = nwg % NXCD, xcd = wgid % NXCD, off = wgid / NXCD; wgid = (xcd < r ? xcd * (q + 1) : r * (q + 1) + (xcd - r) * q) + off; }
        const int nig = WGM * nN, gid = wgid / nig, fm = gid * WGM, gsz = (nM - fm) < WGM ? (nM - fm) : WGM;
        u.pm = pm0 + fm + ((wgid % nig) % gsz); u.pn = (wgid % nig) / gsz; return true;
    }
};

template <class Epi>
__device__ __forceinline__ void gemm_phase(LAS unsigned char* lds, const Gemm g, const StaticOrder& S, const Epi& E) {
    const int tid = tidx(), wid = __builtin_amdgcn_readfirstlane(tid >> 6), lane = tid & 63, wr = wid >> 2, wc = wid & 3, fr = lane & 15, fq = lane >> 4;
    const int K = g.K, nt = K / BK;
    unsigned voffA[2], voffB[2];
#pragma unroll
    for (int i = 0; i < 2; ++i) { int R, C; stage_rc(tid * 16 + i * 8192, R, C); const int Rb = (R & ~31) + perm32(R & 31);
        voffA[i] = (unsigned)(R * K + C) * 2u; voffB[i] = (unsigned)(Rb * K + C) * 2u; }
    const size_t kstep = (size_t)(BK * 2);
    const size_t hstep = (size_t)HALF * K * 2;
    const size_t tstep = 2 * hstep;
    const unsigned ldsw = (unsigned)wid * 1024u;
    const int aoff = lds_byte(wr * 64 + fr, fq * 8), boff = lds_byte(wc * 32 + fr, fq * 8);
#define PG8_SA(b, h) (((b) * 2 + (h)) * HTB)
#define PG8_SB(b, h) ((4 + (b) * 2 + (h)) * HTB)
#define PG8_STAGE(bufoff, gbase, voff) do { _Pragma("unroll") for (int _i = 0; _i < 2; ++_i) \
        __builtin_amdgcn_global_load_lds((const unsigned*)((const char*)(gbase) + (voff)[_i]), (LAS unsigned*)(lds + (bufoff) + ldsw + _i * 8192), 16, 0, 0); } while (0)
#define PG8_LDA(dst, b, h) do { _Pragma("unroll") for (int m = 0; m < 4; ++m) _Pragma("unroll") for (int k = 0; k < 2; ++k) dst[m][k] = *(const LAS bf16x8*)(lds + PG8_SA(b, h) + aoff + m * 2048 + k * 1024); } while (0)
#define PG8_LDB(dst, b, h) do { _Pragma("unroll") for (int n = 0; n < 2; ++n) _Pragma("unroll") for (int k = 0; k < 2; ++k) dst[n][k] = *(const LAS bf16x8*)(lds + PG8_SB(b, h) + boff + n * 2048 + k * 1024); } while (0)
#define PG8_MMA(ai, bj, At, Bt) do { __builtin_amdgcn_s_setprio(1); _Pragma("unroll") for (int m = 0; m < 4; ++m) _Pragma("unroll") for (int n = 0; n < 2; ++n) _Pragma("unroll") for (int k = 0; k < 2; ++k) \
        acc[ai][bj][m][n] = __builtin_amdgcn_mfma_f32_16x16x32_bf16(Bt[n][k], At[m][k], acc[ai][bj][m][n], 0, 0, 0); __builtin_amdgcn_s_setprio(0); } while (0)
#define PG8_WAIT_V(n) asm volatile("s_waitcnt vmcnt(" #n ")" ::: "memory")
#define PG8_WAIT_L(n) asm volatile("s_waitcnt lgkmcnt(" #n ")" ::: "memory")
#define PG8_BAR __builtin_amdgcn_s_barrier()
#define PG8_SCHED __builtin_amdgcn_sched_barrier(0)
    Unit cur, nxt; int ui = 0;
    if (!S.next(0, cur)) return;
    f32x4 acc[2][2][4][2];
#pragma unroll
    for (int a = 0; a < 2; ++a)
#pragma unroll
        for (int b = 0; b < 2; ++b)
#pragma unroll
            for (int m = 0; m < 4; ++m)
#pragma unroll
                for (int n = 0; n < 2; ++n) acc[a][b][m][n] = (f32x4){0.f, 0.f, 0.f, 0.f};
    bf16x8 At[4][2], B0[2][2], B1[2][2];
    const char* cA = selA(g, cur.sel) + (size_t)cur.pm * tstep; const char* cB = selB(g, cur.sel) + (size_t)cur.pn * tstep;
    PG8_STAGE(PG8_SB(0, 0), cB, voffB); PG8_STAGE(PG8_SA(0, 0), cA, voffA); PG8_STAGE(PG8_SB(0, 1), cB + hstep, voffB); PG8_STAGE(PG8_SA(0, 1), cA + hstep, voffA);
    if (wr == 1) PG8_BAR;
    PG8_WAIT_V(4); PG8_BAR;
    PG8_STAGE(PG8_SB(1, 0), cB + kstep, voffB); PG8_STAGE(PG8_SA(1, 0), cA + kstep, voffA); PG8_STAGE(PG8_SB(1, 1), cB + hstep + kstep, voffB);
    PG8_WAIT_V(6); PG8_BAR;
    for (;;) {
        const bool has_next = S.next(ui + 1, nxt);
        const char* nA = has_next ? selA(g, nxt.sel) + (size_t)nxt.pm * tstep : cA; const char* nB = has_next ? selB(g, nxt.sel) + (size_t)nxt.pn * tstep : cB;
        for (int t = 0; t < nt; t += 2) {
            const bool last = (t == nt - 2);
            const char* a1 = cA + (size_t)(t + 1) * kstep;
            const char* a2 = last ? nA : cA + (size_t)(t + 2) * kstep; const char* b2 = last ? nB : cB + (size_t)(t + 2) * kstep;
            const char* a3 = a2 + kstep; const char* b3 = b2 + kstep;
            PG8_LDB(B0, 0, 0); PG8_SCHED; PG8_LDA(At, 0, 0); PG8_STAGE(PG8_SA(1, 1), a1 + hstep, voffA);
            PG8_WAIT_L(8); PG8_BAR; PG8_WAIT_L(0); PG8_MMA(0, 0, At, B0); PG8_BAR; PG8_SCHED;
            PG8_LDB(B1, 0, 1); PG8_STAGE(PG8_SB(0, 0), b2, voffB);
            PG8_BAR; PG8_WAIT_L(0); PG8_MMA(0, 1, At, B1); PG8_BAR;
            PG8_LDA(At, 0, 1); PG8_STAGE(PG8_SA(0, 0), a2, voffA);
            PG8_BAR; PG8_WAIT_L(0); PG8_MMA(1, 0, At, B0); PG8_BAR; PG8_SCHED;
            PG8_STAGE(PG8_SB(0, 1), b2 + hstep, voffB);
            PG8_WAIT_V(6); PG8_BAR; PG8_MMA(1, 1, At, B1); PG8_BAR;
            PG8_LDB(B0, 1, 0); PG8_SCHED; PG8_LDA(At, 1, 0); PG8_STAGE(PG8_SA(0, 1), a2 + hstep, voffA);
            PG8_WAIT_L(8); PG8_BAR; PG8_WAIT_L(0); PG8_MMA(0, 0, At, B0); PG8_BAR; PG8_SCHED;
            PG8_LDB(B1, 1, 1); PG8_STAGE(PG8_SB(1, 0), b3, voffB);
            PG8_BAR; PG8_WAIT_L(0); PG8_MMA(0, 1, At, B1); PG8_BAR;
            PG8_LDA(At, 1, 1); PG8_STAGE(PG8_SA(1, 0), a3, voffA);
            PG8_BAR; PG8_WAIT_L(0); PG8_MMA(1, 0, At, B0); PG8_BAR; PG8_SCHED;
            PG8_STAGE(PG8_SB(1, 1), b3 + hstep, voffB);
            PG8_WAIT_V(6); PG8_BAR; PG8_MMA(1, 1, At, B1); PG8_BAR;
        }
        bool keep = false;
        if constexpr (Epi::CHAIN) keep = E.chain(acc, cur, wr, wc, fr, fq); else E(acc, cur, wr, wc, fr, fq);
        if (!has_next) break;
        if (!keep) {
#pragma unroll
        for (int a = 0; a < 2; ++a)
#pragma unroll
            for (int b = 0; b < 2; ++b)
#pragma unroll
                for (int m = 0; m < 4; ++m)
#pragma unroll
                    for (int n = 0; n < 2; ++n) acc[a][b][m][n] = (f32x4){0.f, 0.f, 0.f, 0.f};
        }
        cur = nxt; cA = nA; cB = nB; ++ui;
    }
    PG8_WAIT_V(0);
    if (wr == 0) PG8_BAR;
    PG8_BAR;
#undef PG8_SA
#undef PG8_SB
#undef PG8_STAGE
#undef PG8_LDA
#undef PG8_LDB
#undef PG8_MMA
#undef PG8_WAIT_V
#undef PG8_WAIT_L
#undef PG8_BAR
#undef PG8_SCHED
}
}

typedef f32x4 AccT[2][2][4][2];
__device__ __forceinline__ u32x4 pack8(const f32x4 a, const f32x4 b) { u32x4 w; w.x = cvt_pk_bf16(a[0], a[1]); w.y = cvt_pk_bf16(a[2], a[3]); w.z = cvt_pk_bf16(b[0], b[1]); w.w = cvt_pk_bf16(b[2], b[3]); return w; }
__device__ __forceinline__ void unpack8(const u32x4 w, f32x4& a, f32x4& b) { a = (f32x4){bflo(w.x), bfhi(w.x), bflo(w.y), bfhi(w.y)}; b = (f32x4){bflo(w.z), bfhi(w.z), bflo(w.w), bfhi(w.w)}; }

__device__ __forceinline__ float row_rs(const float* part, int r, int fq) {
    const float* pp = part + (size_t)r * 64 + fq * 16; const f32x4 a = *(const f32x4*)pp, b = *(const f32x4*)(pp + 4), c = *(const f32x4*)(pp + 8), d = *(const f32x4*)(pp + 12);
    float s = ((a[0] + a[1]) + (a[2] + a[3])) + ((b[0] + b[1]) + (b[2] + b[3])) + ((c[0] + c[1]) + (c[2] + c[3])) + ((d[0] + d[1]) + (d[2] + d[3])); s += __shfl_xor(s, 16); s += __shfl_xor(s, 32);
    return rsqrtf(s * (1.0f / DM) + EPS);
}
struct EpiIn {   static constexpr bool CHAIN = false;
    bf16_t* P; float* glr; const float* cosT; const float* sinT; const float* ss;
    __device__ __forceinline__ void operator()(const AccT& acc, const pg8::Unit& u, int wr, int wc, int fr, int fq) const {
        const int pn = u.pn; const int row0 = u.pm * 256 + wr * 64 + fr;
        int mode = 0; float scale = 1.0f;
        if (pn < 8) { mode = 1; scale = pn >= 4 ? 0.08838834764831845f : 1.0f; }
        else if ((pn >= 12 && pn < 16) || (pn >= 24 && pn < 28) || (pn >= 32 && pn < 36)) mode = 2;
        else if (pn >= 36 && pn < 60) mode = 3;
        else if (pn == 60) mode = 4;
        else if (pn == 16 || pn == 17) scale = 0.08838834764831845f;
        if (mode == 4) {
            if (wc == 0) {
#pragma unroll
                for (int ai = 0; ai < 2; ++ai)
#pragma unroll
                    for (int m = 0; m < 4; ++m) { const int r = row0 + ai * 128 + m * 16; const float rs = row_rs(ss, r, fq);
                        if (fq < 2) { float* gp = glr + (size_t)r * 16 + 8 * fq; *(f32x4*)gp = acc[ai][0][m][0] * rs; *(f32x4*)(gp + 4) = acc[ai][0][m][1] * rs; } }
            }
            return;
        }
        const int i4 = 4 * (4 * wc + fq);
        float rsv[2][4];
#pragma unroll
        for (int ai = 0; ai < 2; ++ai)
#pragma unroll
            for (int m = 0; m < 4; ++m) rsv[ai][m] = row_rs(ss, row0 + ai * 128 + m * 16, fq);
#pragma unroll
        for (int ai = 0; ai < 2; ++ai)
#pragma unroll
            for (int m = 0; m < 4; ++m) {
                const int r = row0 + ai * 128 + m * 16; const float rs = rsv[ai][m];
                bf16_t* rowp = P + (size_t)r * PLD + pn * 256 + wc * 32 + 8 * fq;
                f32x4 cs = (f32x4){1.f, 1.f, 1.f, 1.f}, sn = (f32x4){0.f, 0.f, 0.f, 0.f};
                if (mode == 1) { const int pos = r >= ROW0 ? r - ROW0 : 0; cs = *(const f32x4*)(cosT + (size_t)pos * 64 + i4); sn = *(const f32x4*)(sinT + (size_t)pos * 64 + i4); }
#pragma unroll
                for (int bj = 0; bj < 2; ++bj) {
                    f32x4 v0 = acc[ai][bj][m][0] * rs, v1 = acc[ai][bj][m][1] * rs;
                    if (mode == 1) { const f32x4 o1 = v0 * cs - v1 * sn, o2 = v0 * sn + v1 * cs; v0 = o1 * scale; v1 = o2 * scale; }
                    else if (mode == 2) {
#pragma unroll
                        for (int j = 0; j < 4; ++j) { v0[j] = siluf_(v0[j]); v1[j] = siluf_(v1[j]); } }
                    else if (mode == 3) {
#pragma unroll
                        for (int j = 0; j < 4; ++j) { v0[j] = sigmoidf_(v0[j]); v1[j] = sigmoidf_(v1[j]); } }
                    else { v0 = v0 * scale; v1 = v1 * scale; }
                    *(u32x4*)(rowp + bj * 128) = pack8(v0, v1);
                }
            }
    }
};
#define EPI_MAIN_LOOP \
        const int row0 = u.pm * 256 + wr * 64 + fr, col0 = u.pn * 256 + wc * 32 + 8 * fq; \
        _Pragma("unroll") for (int ai = 0; ai < 2; ++ai) _Pragma("unroll") for (int m = 0; m < 4; ++m) _Pragma("unroll") for (int bj = 0; bj < 2; ++bj) \
            seg(row0 + ai * 128 + m * 16, col0 + bj * 128, acc[ai][bj][m][0], acc[ai][bj][m][1], u.sel);
struct EpiGlu {
    static constexpr bool CHAIN = false;
    const bf16_t* sopre; const bf16_t* P; bf16_t* so;
    __device__ __forceinline__ void seg(int r, int c, f32x4 v0, f32x4 v1, int sel) const {
        const u32x4 sp = *(const u32x4*)(sopre + (size_t)r * 1024 + c), gt = *(const u32x4*)(P + (size_t)r * PLD + C_SG + c);
        f32x4 s0, s1, g0, g1; unpack8(sp, s0, s1); unpack8(gt, g0, g1);
#pragma unroll
        for (int j = 0; j < 4; ++j) { v0[j] = s0[j] * sigmoidf_(v0[j]) * g0[j]; v1[j] = s1[j] * sigmoidf_(v1[j]) * g1[j]; }
        *(u32x4*)(so + (size_t)r * 1024 + c) = pack8(v0, v1);
    }
    __device__ __forceinline__ void operator()(const AccT& acc, const pg8::Unit& u, int wr, int wc, int fr, int fq) const {
        const int row0 = u.pm * 256 + wr * 64 + fr, col0 = u.pn * 256 + wc * 32 + 8 * fq;
#pragma unroll
        for (int ai = 0; ai < 2; ++ai) { u32x4 sp[4][2], gt[4][2];
#pragma unroll
            for (int m = 0; m < 4; ++m)
#pragma unroll
                for (int bj = 0; bj < 2; ++bj) { const int r = row0 + ai * 128 + m * 16, c = col0 + bj * 128;
                    sp[m][bj] = *(const u32x4*)(sopre + (size_t)r * 1024 + c); gt[m][bj] = *(const u32x4*)(P + (size_t)r * PLD + C_SG + c); }
#pragma unroll
            for (int m = 0; m < 4; ++m)
#pragma unroll
                for (int bj = 0; bj < 2; ++bj) { const int r = row0 + ai * 128 + m * 16, c = col0 + bj * 128;
                    f32x4 s0, s1, g0, g1; unpack8(sp[m][bj], s0, s1); unpack8(gt[m][bj], g0, g1); f32x4 v0 = acc[ai][bj][m][0], v1 = acc[ai][bj][m][1];
#pragma unroll
                    for (int j = 0; j < 4; ++j) { v0[j] = s0[j] * sigmoidf_(v0[j]) * g0[j]; v1[j] = s1[j] * sigmoidf_(v1[j]) * g1[j]; }
                    *(u32x4*)(so + (size_t)r * 1024 + c) = pack8(v0, v1); } }
    }
};
struct EpiBr {
    static constexpr bool CHAIN = true;
    const bf16_t* P; float* yacc; bf16_t* y;
    __device__ __forceinline__ void seg(int r, int c, f32x4 v0, f32x4 v1, int sel) const {
        const u32x4 gt = *(const u32x4*)(P + (size_t)r * PLD + C_MG + sel * 2048 + c);
        f32x4 g0, g1; unpack8(gt, g0, g1); v0 = v0 * g0; v1 = v1 * g1;
        float* yp = yacc + (size_t)r * DM + c;
        if (sel > 0) { v0 = v0 + *(const f32x4*)yp; v1 = v1 + *(const f32x4*)(yp + 4); }
        if (sel < 2) { *(f32x4*)yp = v0; *(f32x4*)(yp + 4) = v1; }
        else *(u32x4*)(y + (size_t)r * DM + c) = pack8(v0, v1);
    }
    __device__ __forceinline__ bool chain(AccT& acc, const pg8::Unit& u, int wr, int wc, int fr, int fq) const {
        const int row0 = u.pm * 256 + wr * 64 + fr, col0 = u.pn * 256 + wc * 32 + 8 * fq; const int sel = u.sel;
#pragma unroll
        for (int ai = 0; ai < 2; ++ai) { u32x4 gc[4][2], gn[4][2];
#pragma unroll
            for (int m = 0; m < 4; ++m)
#pragma unroll
                for (int bj = 0; bj < 2; ++bj) { const bf16_t* gp = P + (size_t)(row0 + ai * 128 + m * 16) * PLD + C_MG + sel * 2048 + col0 + bj * 128;
                    gc[m][bj] = *(const u32x4*)gp; gn[m][bj] = sel < 2 ? *(const u32x4*)(gp + 2048) : gc[m][bj]; }
#pragma unroll
            for (int m = 0; m < 4; ++m)
#pragma unroll
                for (int bj = 0; bj < 2; ++bj) { const int r = row0 + ai * 128 + m * 16, c = col0 + bj * 128;
                    f32x4 g0, g1; unpack8(gc[m][bj], g0, g1);
                    if (sel < 2) { f32x4 n0, n1; unpack8(gn[m][bj], n0, n1);
#pragma unroll
                        for (int j = 0; j < 4; ++j) { acc[ai][bj][m][0][j] *= g0[j] * __builtin_amdgcn_rcpf(fmaxf(n0[j], 1e-20f)); acc[ai][bj][m][1][j] *= g1[j] * __builtin_amdgcn_rcpf(fmaxf(n1[j], 1e-20f)); } }
                    else *(u32x4*)(y + (size_t)r * DM + c) = pack8(acc[ai][bj][m][0] * g0, acc[ai][bj][m][1] * g1); } }
        return sel < 2;
    }
};
struct EpiOut {
    static constexpr bool CHAIN = false;
    float* H; bf16_t* HN; const float* gnext; float* ssn;
    __device__ __forceinline__ void seg(int r, int c, f32x4 v0, f32x4 v1, int sel) const {
        float* hp = H + (size_t)r * DM + c;
        const f32x4 a = *(const f32x4*)hp + v0, b = *(const f32x4*)(hp + 4) + v1;
        *(f32x4*)hp = a; *(f32x4*)(hp + 4) = b;
        float sq = a[0] * a[0] + a[1] * a[1] + a[2] * a[2] + a[3] * a[3] + b[0] * b[0] + b[1] * b[1] + b[2] * b[2] + b[3] * b[3];
        if (gnext) { const f32x4 g0 = *(const f32x4*)(gnext + c), g1 = *(const f32x4*)(gnext + c + 4); *(u32x4*)(HN + (size_t)r * DM + c) = pack8(a * g0, b * g1); }
        sq += __shfl_xor(sq, 16); sq += __shfl_xor(sq, 32);
        if ((c & 31) == 0) ssn[(size_t)r * 64 + (c >> 5)] = sq;
    }
    __device__ __forceinline__ void operator()(const AccT& acc, const pg8::Unit& u, int wr, int wc, int fr, int fq) const {
        const int row0 = u.pm * 256 + wr * 64 + fr, col0 = u.pn * 256 + wc * 32 + 8 * fq;
#pragma unroll
        for (int ai = 0; ai < 2; ++ai) { f32x4 ha[4][2], hb[4][2];
#pragma unroll
            for (int m = 0; m < 4; ++m)
#pragma unroll
                for (int bj = 0; bj < 2; ++bj) { const float* hp = H + (size_t)(row0 + ai * 128 + m * 16) * DM + col0 + bj * 128; ha[m][bj] = *(const f32x4*)hp; hb[m][bj] = *(const f32x4*)(hp + 4); }
#pragma unroll
            for (int m = 0; m < 4; ++m)
#pragma unroll
                for (int bj = 0; bj < 2; ++bj) { const int r = row0 + ai * 128 + m * 16, c = col0 + bj * 128; float* hp = H + (size_t)r * DM + c;
                    const f32x4 a = ha[m][bj] + acc[ai][bj][m][0], b = hb[m][bj] + acc[ai][bj][m][1];
                    *(f32x4*)hp = a; *(f32x4*)(hp + 4) = b;
                    float sq = a[0] * a[0] + a[1] * a[1] + a[2] * a[2] + a[3] * a[3] + b[0] * b[0] + b[1] * b[1] + b[2] * b[2] + b[3] * b[3];
                    if (gnext) { const f32x4 g0 = *(const f32x4*)(gnext + c), g1 = *(const f32x4*)(gnext + c + 4); *(u32x4*)(HN + (size_t)r * DM + c) = pack8(a * g0, b * g1); }
                    sq += __shfl_xor(sq, 16); sq += __shfl_xor(sq, 32);
                    if (fq == 0) ssn[(size_t)r * 64 + (c >> 5)] = sq; } }
    }
};

template <class Epi>
__device__ __forceinline__ void skinny_phase(LAS unsigned char* lds, const bf16_t* A, const bf16_t* Wt, size_t selA, size_t selB, int K, int N, int sel0, int sel1, const Epi& E, int bid, int nb) {
    const int t = tidx(), w = t >> 6, lane = t & 63, l15 = lane & 15, g = lane >> 4;
    LAS float* red = (LAS float*)lds;
    const int ksteps = K / 256;
    for (int grp = bid; grp < N / 32; grp += nb) {
        const int n0 = grp * 32;
        for (int sel = sel0; sel < sel1; ++sel) {
            const bf16_t* Ab = (const bf16_t*)((const char*)A + (size_t)sel * selA) + (size_t)(ROW0 + l15) * K + (size_t)w * (K / 8) + 8 * g;
            const bf16_t* Wb = (const bf16_t*)((const char*)Wt + (size_t)sel * selB) + (size_t)(n0 + 8 * (l15 >> 2) + (l15 & 3)) * K + (size_t)w * (K / 8) + 8 * g;
            f32x4 acc0 = (f32x4){0.f, 0.f, 0.f, 0.f}, acc1 = (f32x4){0.f, 0.f, 0.f, 0.f};
#pragma unroll 4
            for (int ks = 0; ks < ksteps; ++ks) {
                const bf16x8 a0 = *(const bf16x8*)(Wb + ks * 32), a1 = *(const bf16x8*)(Wb + (size_t)4 * K + ks * 32), bb = *(const bf16x8*)(Ab + ks * 32);
                acc0 = MFMA16(a0, bb, acc0); acc1 = MFMA16(a1, bb, acc1);
            }
            *(LAS f32x4*)(red + (w * 64 + lane) * 8) = acc0; *(LAS f32x4*)(red + (w * 64 + lane) * 8 + 4) = acc1;
            __syncthreads();
            if (w == 0) {
                f32x4 v0 = (f32x4){0.f, 0.f, 0.f, 0.f}, v1 = (f32x4){0.f, 0.f, 0.f, 0.f};
#pragma unroll
                for (int k = 0; k < 8; ++k) { v0 = v0 + *(const LAS f32x4*)(red + (k * 64 + lane) * 8); v1 = v1 + *(const LAS f32x4*)(red + (k * 64 + lane) * 8 + 4); }
                E.seg(ROW0 + l15, n0 + 8 * g, v0, v1, sel);
            }
            __syncthreads();
        }
    }
}

__device__ __forceinline__ int win_dst_row(int c) {
    if (c < 2048) { const int hd = c >> 7, d = c & 127, i = d & 63, half = d >> 6; return (hd << 7) + 8 * (i >> 2) + 4 * half + (i & 3); }
    if (c < 7168) return c;
    if (c < 7184) return 15360 + (c - 7168);
    return c - 16;
}
__device__ __forceinline__ void cvt_tile(LAS unsigned char* lds, const float* src, int K, int Ns, bf16_t* dst, int k0, int n0, bool winmap) {
    const int t = tidx(); LAS float* T = (LAS float*)lds;
    { const int n4 = (t & 15) * 4, kk = t >> 4;
        f32x4 v[4];
#pragma unroll
        for (int i = 0; i < 4; ++i) { const int k = kk + 32 * i; v[i] = (n0 + n4 < Ns) ? *(const f32x4*)(src + (size_t)(k0 + k) * Ns + n0 + n4) : (f32x4){0.f, 0.f, 0.f, 0.f}; }
#pragma unroll
        for (int i = 0; i < 4; ++i) { const int k = kk + 32 * i; *(LAS f32x4*)(T + k * 64 + ((n4 + 8 * ((k >> 4) & 7)) & 63)) = v[i]; } }
    __syncthreads();
    { const int n = t >> 3, seg = t & 7; const int nn = (n + 8 * seg) & 63;
        float f[16];
#pragma unroll
        for (int q = 0; q < 16; ++q) f[q] = T[(seg * 16 + q) * 64 + nn];
        if (n0 + n < Ns) { const int dr = winmap ? win_dst_row(n0 + n) : (n0 + n);
            u32x4 a, b2; a.x = cvt_pk_bf16(f[0], f[1]); a.y = cvt_pk_bf16(f[2], f[3]); a.z = cvt_pk_bf16(f[4], f[5]); a.w = cvt_pk_bf16(f[6], f[7]);
            b2.x = cvt_pk_bf16(f[8], f[9]); b2.y = cvt_pk_bf16(f[10], f[11]); b2.z = cvt_pk_bf16(f[12], f[13]); b2.w = cvt_pk_bf16(f[14], f[15]);
            bf16_t* dp = dst + (size_t)dr * K + k0 + seg * 16; *(u32x4*)dp = a; *(u32x4*)(dp + 8) = b2; } }
    __syncthreads();
}
__device__ __forceinline__ void phase_prep(KA ka, unsigned char* ws, LAS unsigned char* lds, int bid, int nb) {
    const int t = tidx();
    constexpr int T_IN = 16 * 241, T_GLU = 8 * 16, T_BR = 8 * 32, T_OUT = 16 * 32, T_L = T_IN + T_GLU + 3 * T_BR + T_OUT;
    for (int tile = bid; tile < DEPTH * T_L; tile += nb) {
        const int l = tile / T_L; int r = tile - l * T_L;
        if (r < T_IN) { cvt_tile(lds, PF(w_in) + (size_t)l * DM * NIN_SRC, DM, NIN_SRC, (bf16_t*)(ws + WS_WIN) + (size_t)l * NIN_T * DM, (r / 241) * 128, (r % 241) * 64, true); continue; }
        r -= T_IN;
        if (r < T_GLU) { cvt_tile(lds, PF(s5_wglu) + (size_t)l * 1024 * 1024, 1024, 1024, (bf16_t*)(ws + WS_WGLU) + (size_t)l * 1024 * 1024, (r / 16) * 128, (r % 16) * 64, false); continue; }
        r -= T_GLU;
        if (r < 3 * T_BR) { const int b = r / T_BR; r -= b * T_BR; const float* src = (b == 0 ? PF(w_br_ret) : (b == 1 ? PF(w_br_gla) : PF(w_br_s5))) + (size_t)l * 1024 * 2048;
            cvt_tile(lds, src, 1024, 2048, (bf16_t*)(ws + WS_WBR) + (size_t)(l * 3 + b) * 2048 * 1024, (r / 32) * 128, (r % 32) * 64, false); continue; }
        r -= 3 * T_BR;
        cvt_tile(lds, PF(w_out) + (size_t)l * 2048 * 2048, 2048, 2048, (bf16_t*)(ws + WS_WOUT) + (size_t)l * 2048 * 2048, (r / 32) * 128, (r % 32) * 64, false);
    }
    const size_t gtid = (size_t)bid * NT + t, gsz = (size_t)nb * NT;
    for (size_t i = gtid; i < (size_t)DEPTH * 240 * DM / 8; i += gsz) { const size_t l = i / (240 * DM / 8), o = i % (240 * DM / 8);
        *(u32x4*)((bf16_t*)(ws + WS_WIN) + (l * NIN_T + 15376) * DM + o * 8) = (u32x4){0u, 0u, 0u, 0u}; }
    { float* H = (float*)(ws + WS_H); bf16_t* HN = (bf16_t*)(ws + WS_HN); float* SS = (float*)(ws + WS_SS); const int wave = t >> 6, lane = t & 63;
        for (int r = bid * 8 + wave; r < MR; r += nb * 8) { f32x4 v[8]; float ss = 0.f;
#pragma unroll
            for (int j = 0; j < 8; ++j) { const int c = (j * 64 + lane) * 4; v[j] = (f32x4){0.f, 0.f, 0.f, 0.f};
                if (r >= 256) v[j] = *(const f32x4*)(PF(x) + (size_t)(r - 256) * DM + c); else if (r >= ROW0) v[j] = *(const f32x4*)(PF(meta) + (size_t)(r - ROW0) * DM + c);
                ss += v[j][0] * v[j][0] + v[j][1] * v[j][1] + v[j][2] * v[j][2] + v[j][3] * v[j][3]; }
#pragma unroll
            for (int o = 32; o >= 1; o >>= 1) ss += __shfl_xor(ss, o);
#pragma unroll
            for (int j = 0; j < 8; ++j) { const int c = (j * 64 + lane) * 4; const f32x4 gv = *(const f32x4*)(PF(norm_g) + c); const f32x4 o = v[j] * gv;
                *(f32x4*)(H + (size_t)r * DM + c) = v[j]; u32x2 w; w.x = cvt_pk_bf16(o[0], o[1]); w.y = cvt_pk_bf16(o[2], o[3]); *(u32x2*)(HN + (size_t)r * DM + c) = w; }
            SS[(size_t)r * 64 + lane] = lane == 0 ? ss : 0.f; } }
    float* cosT = (float*)(ws + WS_COS); float* sinT = (float*)(ws + WS_SIN);
    for (size_t i = gtid; i < (size_t)MR * 64; i += gsz) { const int pos = (int)(i >> 6), k = (int)(i & 63);
        const float inv = exp2f(-(float)k * (13.287712379549449f / 64.0f)); const float ang = (float)pos * inv; float s, c; sincos_red(ang, s, c); cosT[i] = c; sinT[i] = s; }
    for (size_t i = gtid; i < (size_t)128 * 1024 / 8; i += gsz) { const u32x4 z = (u32x4){0u, 0u, 0u, 0u};
        *(u32x4*)((bf16_t*)(ws + WS_RO) + i * 8) = z; *(u32x4*)((bf16_t*)(ws + WS_GO) + i * 8) = z; *(u32x4*)((bf16_t*)(ws + WS_SOPRE) + i * 8) = z; }
}

__device__ __forceinline__ void phase_rmsnorm(const float* H, const float* g, bf16_t* HN, int bid, int nb) {
    const int wave = tidx() >> 6, lane = tidx() & 63;
    for (int r = bid * 8 + wave; r < MR; r += nb * 8) {
        const float* hp = H + (size_t)r * DM; f32x4 v[8]; float ss = 0.f;
#pragma unroll
        for (int j = 0; j < 8; ++j) { v[j] = *(const f32x4*)(hp + (j * 64 + lane) * 4); ss += v[j][0] * v[j][0] + v[j][1] * v[j][1] + v[j][2] * v[j][2] + v[j][3] * v[j][3]; }
#pragma unroll
        for (int o = 32; o >= 1; o >>= 1) ss += __shfl_xor(ss, o);
        const float rs = rsqrtf(ss * (1.0f / DM) + EPS);
#pragma unroll
        for (int j = 0; j < 8; ++j) { const int c = (j * 64 + lane) * 4; const f32x4 gv = *(const f32x4*)(g + c); const f32x4 o = v[j] * rs * gv;
            u32x2 w; w.x = cvt_pk_bf16(o[0], o[1]); w.y = cvt_pk_bf16(o[2], o[3]); *(u32x2*)(HN + (size_t)r * DM + c) = w; }
    }
}
__device__ __forceinline__ void phase_final(const float* H, const float* part, const float* g, float* out, int bid, int nb, float eps) {
    const int wave = tidx() >> 6, lane = tidx() & 63;
    f32x4 gvv[8];
#pragma unroll
    for (int j = 0; j < 8; ++j) gvv[j] = *(const f32x4*)(g + (j * 64 + lane) * 4);
    for (int r = bid * 8 + wave; r < SEQ; r += nb * 8) {
        float ss = part[(size_t)(r + 256) * 64 + lane];
#pragma unroll
        for (int o = 32; o >= 1; o >>= 1) ss += __shfl_xor(ss, o);
        const float rs = rsqrtf(ss * (1.0f / DM) + EPS); const float* hp = H + (size_t)(r + 256) * DM;
        f32x4 v[8];
#pragma unroll
        for (int j = 0; j < 8; ++j) v[j] = *(const f32x4*)(hp + (j * 64 + lane) * 4);
#pragma unroll
        for (int j = 0; j < 8; ++j) { const int c = (j * 64 + lane) * 4; f32x4 o = v[j] * rs * gvv[j];
            if (TK) { for (int e = 0; e < 4; ++e) { const unsigned idx = (unsigned)(r * DM + c + e); o[e] += (__builtin_popcount(idx * 2654435761u) & 1) ? eps : -eps; } }
            *(f32x4*)(out + (size_t)r * DM + c) = o; }
    }
}

constexpr int P128 = 272;
constexpr int P256 = 528;
__device__ __forceinline__ void stage_tile(LAS unsigned char* img, int lp, const bf16_t* g, size_t gp, int ncols) {
    const int segs = ncols >> 3, total = 128 * segs;
    for (int i = tidx(); i < total; i += NT) { const int r = i / segs, s = i - r * segs;
        *(LAS u32x4*)(img + r * lp + s * 16) = *(const u32x4*)(g + (size_t)r * gp + s * 8); }
}
template <int NCOLS> __device__ __forceinline__ void stage_load(u32x4 (&v)[NCOLS / 32], const bf16_t* g, size_t gp) {
    constexpr int segs = NCOLS >> 3;
#pragma unroll
    for (int j = 0; j < NCOLS / 32; ++j) { const int i = tidx() + j * NT, r = i / segs, sg = i - r * segs; v[j] = *(const u32x4*)(g + (size_t)r * gp + sg * 8); }
}
template <int NCOLS> __device__ __forceinline__ void stage_store(const u32x4 (&v)[NCOLS / 32], LAS unsigned char* img, int lp) {
    constexpr int segs = NCOLS >> 3;
#pragma unroll
    for (int j = 0; j < NCOLS / 32; ++j) { const int i = tidx() + j * NT, r = i / segs, sg = i - r * segs; *(LAS u32x4*)(img + r * lp + sg * 16) = v[j]; }
}
__device__ __forceinline__ void stage_tile_kdec(LAS unsigned char* img, int lp, const bf16_t* g, size_t gp, float lg) {
    for (int i = tidx(); i < 128 * 16; i += NT) { const int r = i >> 4, s = i & 15; const float sc = __expf(lg * (float)(127 - r));
        const u32x4 w = *(const u32x4*)(g + (size_t)r * gp + s * 8); f32x4 a, b; unpack8(w, a, b); *(LAS u32x4*)(img + r * lp + s * 16) = pack8(a * sc, b * sc); }
}

__device__ __forceinline__ void gla_gate(KA ka, unsigned char* ws, int l, int n, int h, LAS float* glrS  , LAS float* segT  , float (&bl)[32], float& blast) {
    const int t = tidx(), d = t & 127, seg = t >> 7;
    const float* GLR = (const float*)(ws + WS_GLR);
    for (int i = t; i < 128 * 16 / 4; i += NT) *(LAS f32x4*)(glrS + i * 4) = *(const f32x4*)(GLR + (size_t)n * 128 * 16 + i * 4);
    float wa[16];
#pragma unroll
    for (int r = 0; r < 16; ++r) wa[r] = PF(gla_w_a)[((size_t)l * 16 + r) * 512 + h * 128 + d];
    const float ba = PF(gla_b_a)[(size_t)l * 512 + h * 128 + d];
    __syncthreads();
    float cum = 0.f;
#pragma unroll
    for (int i = 0; i < 32; ++i) { const int s = seg * 32 + i; float x = ba;
#pragma unroll
        for (int r4 = 0; r4 < 4; ++r4) { const f32x4 gv = *(const LAS f32x4*)(glrS + s * 16 + r4 * 4); x += gv[0] * wa[r4 * 4] + gv[1] * wa[r4 * 4 + 1] + gv[2] * wa[r4 * 4 + 2] + gv[3] * wa[r4 * 4 + 3]; }
        float la = logsigmoidf_(x) * (1.0f / 16.0f); if (n * 128 + s < ROW0) la = 0.f;
        cum += la; bl[i] = cum; }
    segT[seg * 128 + d] = cum;
    __syncthreads();
    float pre = 0.f, tot = 0.f;
#pragma unroll
    for (int k = 0; k < 4; ++k) { const float v = segT[k * 128 + d]; tot += v; if (k < seg) pre += v; }
#pragma unroll
    for (int i = 0; i < 32; ++i) bl[i] += pre;
    blast = tot;
}

__device__ __forceinline__ void ret_state_unit(KA ka, unsigned char* ws, LAS unsigned char* lds, int n, int h) {
    const int t = tidx(), w = t >> 6, lane = t & 63;
    const bf16_t* PJ = (const bf16_t*)(ws + WS_PROJ) + (size_t)n * 128 * PLD;
    LAS unsigned char* Kimg = lds; LAS unsigned char* Vimg = lds + 128 * P128;
    const float lg = ret_log_gamma(h);
    stage_tile_kdec(Kimg, P128, PJ + C_RK + h * 128, PLD, lg);
    stage_tile(Vimg, P128, PJ + C_RV + h * 128, PLD, 128);
    __syncthreads();
    const int d0 = (w >> 1) * 32, v0 = (w & 1) * 64;
    f32x4 acc[2][4];
#pragma unroll
    for (int a = 0; a < 2; ++a)
#pragma unroll
        for (int b = 0; b < 4; ++b) acc[a][b] = (f32x4){0.f, 0.f, 0.f, 0.f};
#pragma unroll
    for (int ks = 0; ks < 4; ++ks) { bf16x8 a[2], b[4];
#pragma unroll
        for (int mi = 0; mi < 2; ++mi) a[mi] = frag_tr(Kimg, P128, 32 * ks, d0 + 16 * mi, lane);
#pragma unroll
        for (int ni = 0; ni < 4; ++ni) b[ni] = frag_tr(Vimg, P128, 32 * ks, v0 + 16 * ni, lane);
#pragma unroll
        for (int mi = 0; mi < 2; ++mi)
#pragma unroll
            for (int ni = 0; ni < 4; ++ni) acc[mi][ni] = MFMA16(a[mi], b[ni], acc[mi][ni]); }
    float* KV = (float*)(ws + WS_RKV) + (size_t)(n * 8 + h) * 128 * 128;
#pragma unroll
    for (int mi = 0; mi < 2; ++mi)
#pragma unroll
        for (int ni = 0; ni < 4; ++ni)
#pragma unroll
            for (int r = 0; r < 4; ++r) KV[(d0 + 16 * mi + 4 * (lane >> 4) + r) * 128 + v0 + 16 * ni + (lane & 15)] = acc[mi][ni][r];
    __syncthreads();
}
__device__ __forceinline__ void gla_state_unit(KA ka, unsigned char* ws, LAS unsigned char* lds, int l, int n, int h) {
    const int t = tidx(), w = t >> 6, lane = t & 63, d = t & 127, seg = t >> 7;
    const bf16_t* PJ = (const bf16_t*)(ws + WS_PROJ) + (size_t)n * 128 * PLD;
    LAS unsigned char* Kimg = lds; LAS unsigned char* Vimg = lds + 128 * P128;
    LAS float* glrS = (LAS float*)(lds + 128 * P128 + 128 * P256); LAS float* segT = glrS + 128 * 16;
    u32x4 vt[8]; stage_load<256>(vt, PJ + C_GV + h * 256, PLD);
    bf16_t kraw[32];
#pragma unroll
    for (int i = 0; i < 32; ++i) kraw[i] = PJ[(size_t)(seg * 32 + i) * PLD + C_GK + h * 128 + d];
    float bl[32], blast;
    gla_gate(ka, ws, l, n, h, glrS, segT, bl, blast);
#pragma unroll
    for (int i = 0; i < 32; ++i) { const int s = seg * 32 + i; const float k = bf2f(kraw[i]);
        *(LAS bf16_t*)(Kimg + s * P128 + d * 2) = f2bf(k * __expf(blast - bl[i])); }
    if (seg == 0) ((float*)(ws + WS_GDEC))[(size_t)(n * 4 + h) * 128 + d] = __expf(blast);
    stage_store<256>(vt, Vimg, P256);
    __syncthreads();
    const int d0 = (w >> 2) * 64, v0 = (w & 3) * 64;
    f32x4 acc[4][4];
#pragma unroll
    for (int a = 0; a < 4; ++a)
#pragma unroll
        for (int b = 0; b < 4; ++b) acc[a][b] = (f32x4){0.f, 0.f, 0.f, 0.f};
#pragma unroll
    for (int ks = 0; ks < 4; ++ks) { bf16x8 a[4], b[4];
#pragma unroll
        for (int mi = 0; mi < 4; ++mi) a[mi] = frag_tr(Kimg, P128, 32 * ks, d0 + 16 * mi, lane);
#pragma unroll
        for (int ni = 0; ni < 4; ++ni) b[ni] = frag_tr(Vimg, P256, 32 * ks, v0 + 16 * ni, lane);
#pragma unroll
        for (int mi = 0; mi < 4; ++mi)
#pragma unroll
            for (int ni = 0; ni < 4; ++ni) acc[mi][ni] = MFMA16(a[mi], b[ni], acc[mi][ni]); }
    float* KV = (float*)(ws + WS_GKV) + (size_t)(n * 4 + h) * 128 * 256;
#pragma unroll
    for (int mi = 0; mi < 4; ++mi)
#pragma unroll
        for (int ni = 0; ni < 4; ++ni)
#pragma unroll
            for (int r = 0; r < 4; ++r) KV[(d0 + 16 * mi + 4 * (lane >> 4) + r) * 256 + v0 + 16 * ni + (lane & 15)] = acc[mi][ni][r];
    __syncthreads();
}

__device__ __forceinline__ void s5_disc(KA ka, int l, int g, int pp, float& ar, float& ai, float& fre, float& fim) {
    const float dt = __expf(PF(s5_logdt)[l * 64 + g]); const float lr = PF(s5_lre)[(size_t)(l * 64 + g) * 64 + pp], li = PF(s5_lim)[(size_t)(l * 64 + g) * 64 + pp];
    const float mag = __expf(lr * dt); float s, c; sincos_red(li * dt, s, c); ar = mag * c; ai = mag * s;
    const float den = lr * lr + li * li, nr = ar - 1.0f, ni = ai; fre = (nr * lr + ni * li) / den; fim = (ni * lr - nr * li) / den;
}
constexpr int S5_U = 0;
constexpr int S5_W = 128 * P128;
constexpr int S5_WB = 16 * 132 * 4 + 16 * P128;
__device__ __forceinline__ void s5_task(KA ka, unsigned char* ws, LAS unsigned char* lds, int l, int n, int j, int mode) {
    const int t = tidx(), w = t >> 6, lane = t & 63, l15 = lane & 15, g4 = lane >> 4, g = 8 * j + w;
    const bf16_t* PJ = (const bf16_t*)(ws + WS_PROJ) + (size_t)n * 128 * PLD;
    LAS unsigned char* Uimg = lds + S5_U; LAS float* BU = (LAS float*)(lds + S5_W + w * S5_WB); LAS unsigned char* Hw = lds + S5_W + w * S5_WB + 16 * 132 * 4;
    u32x4 ut[4]; stage_load<128>(ut, PJ + C_SU + 128 * j, PLD);
    bf16x8 bbf[8], cfr[4];
    { const size_t gb = (size_t)(l * 64 + g) * 64;
#pragma unroll
        for (int q = 0; q < 4; ++q) { const int pp = 16 * q + l15; float ar, ai, fre, fim; s5_disc(ka, l, g, pp, ar, ai, fre, fim);
            f32x4 br0 = (f32x4){0.f, 0.f, 0.f, 0.f}, br1 = br0, bi0 = br0, bi1 = br0;
            if (g4 < 2) { const float* pr = PF(s5_bre) + (gb + pp) * 16 + 8 * g4; const float* pi = PF(s5_bim) + (gb + pp) * 16 + 8 * g4;
                br0 = *(const f32x4*)pr; br1 = *(const f32x4*)(pr + 4); bi0 = *(const f32x4*)pi; bi1 = *(const f32x4*)(pi + 4); }
            const u32x4 re = pack8(br0 * fre - bi0 * fim, br1 * fre - bi1 * fim), im = pack8(bi0 * fre + br0 * fim, bi1 * fre + br1 * fim);
            bbf[q] = __builtin_bit_cast(bf16x8, re); bbf[4 + q] = __builtin_bit_cast(bf16x8, im); }
        const size_t cb = ((size_t)(l * 64 + g) * 16 + l15) * 64;
#pragma unroll
        for (int ks = 0; ks < 4; ++ks) { const float* pc = (ks < 2 ? PF(s5_cre) : PF(s5_cim)) + cb + 32 * (ks & 1) + 8 * g4; const float sg = ks < 2 ? 1.0f : -1.0f;
            const f32x4 c0 = *(const f32x4*)pc, c1 = *(const f32x4*)(pc + 4); cfr[ks] = __builtin_bit_cast(bf16x8, pack8(c0 * sg, c1 * sg)); } }
    float ar, ai; { float fre, fim; s5_disc(ka, l, g, lane, ar, ai, fre, fim); }
    float hr = 0.f, hi = 0.f;
    if (mode == 1) { const float* Hs = (const float*)(ws + WS_S5H) + ((size_t)(n * 64 + g) * 64 + lane) * 2; hr = Hs[0]; hi = Hs[1]; }
    const float dd = PF(s5_d)[(size_t)l * 1024 + g * 16 + l15];
    stage_store<128>(ut, Uimg, P128);
    __syncthreads();
#pragma unroll 1
    for (int sc = 0; sc < 8; ++sc) {
        const int t0 = 16 * sc;
        bf16x8 a = (bf16x8){0, 0, 0, 0, 0, 0, 0, 0};
        if (g4 < 2) a = *(const LAS bf16x8*)(Uimg + (t0 + l15) * P128 + (w * 16 + 8 * g4) * 2);
#pragma unroll
        for (int ni = 0; ni < 8; ++ni) { f32x4 acc = (f32x4){0.f, 0.f, 0.f, 0.f}; acc = MFMA16(a, bbf[ni], acc);
#pragma unroll
            for (int r = 0; r < 4; ++r) BU[(4 * g4 + r) * 132 + 16 * ni + l15] = acc[r]; }
        __syncthreads();
#pragma unroll
        for (int i = 0; i < 16; ++i) { const float bur = BU[i * 132 + lane], bui = BU[i * 132 + 64 + lane];
            const float nr = ar * hr - ai * hi + bur, ni = ar * hi + ai * hr + bui; hr = nr; hi = ni;
            if (mode == 1) { *(LAS bf16_t*)(Hw + i * P128 + lane * 2) = f2bf(hr); *(LAS bf16_t*)(Hw + i * P128 + (64 + lane) * 2) = f2bf(hi); } }
        if (mode == 1) {
            __syncthreads();
            f32x4 acc = (f32x4){0.f, 0.f, 0.f, 0.f};
#pragma unroll
            for (int ks = 0; ks < 4; ++ks) { const bf16x8 ha = frag_row(Hw, P128, 0, 32 * ks, lane); acc = MFMA16(ha, cfr[ks], acc); }
#pragma unroll
            for (int r = 0; r < 4; ++r) { LAS bf16_t* up = (LAS bf16_t*)(Uimg + (t0 + 4 * g4 + r) * P128 + (w * 16 + l15) * 2); const float u = bf2f(*up); *up = f2bf(geluf_(acc[r] + dd * u)); }
        }
    }
    if (mode == 0) { float* E = (float*)(ws + WS_S5E) + ((size_t)(n * 64 + g) * 64 + lane) * 2; E[0] = hr; E[1] = hi; }
    else { __syncthreads();
        bf16_t* SP = (bf16_t*)(ws + WS_SOPRE) + (size_t)n * 128 * 1024 + 128 * j;
        for (int i = t; i < 128 * 16; i += NT) { const int r = i >> 4, sgm = i & 15; *(u32x4*)(SP + (size_t)r * 1024 + sgm * 8) = *(const LAS u32x4*)(Uimg + r * P128 + sgm * 16); } }
    __syncthreads();
}

__device__ __forceinline__ void phase_scan(KA ka, unsigned char* ws, int l, int bid, int nb) {
    const size_t gtid = (size_t)bid * NT + tidx(), gsz = (size_t)nb * NT;
    { const float* KVr = (const float*)(ws + WS_RKV); bf16_t* PVr = (bf16_t*)(ws + WS_RPREV);
      const float* KVg = (const float*)(ws + WS_GKV); bf16_t* PVg = (bf16_t*)(ws + WS_GPREV); const float* DEC = (const float*)(ws + WS_GDEC);
        for (size_t e = gtid; e < (size_t)131072; e += gsz) {
            const int hr_ = (int)(e >> 14); const size_t dvr = e & 16383; const float g128 = __expf(ret_log_gamma(hr_) * 128.0f);
            const int hg = (int)(e >> 15); const size_t dvg = e & 32767; const int d = (int)(dvg >> 8);
            float pr = 0.f, pg = 0.f;
            float kr[2][13], kg[2][13], dc[2][13];
#pragma unroll
            for (int k = 0; k < 13; ++k) { const int n = 1 + k; kr[0][k] = KVr[(size_t)(n * 8 + hr_) * 16384 + dvr]; kg[0][k] = KVg[(size_t)(n * 4 + hg) * 32768 + dvg]; dc[0][k] = DEC[(size_t)(n * 4 + hg) * 128 + d]; }
#pragma unroll
            for (int b = 0; b < 5; ++b) {
                if (b < 4) {
#pragma unroll
                    for (int k = 0; k < 13; ++k) { const int n = 1 + 13 * (b + 1) + k; kr[(b + 1) & 1][k] = KVr[(size_t)(n * 8 + hr_) * 16384 + dvr]; kg[(b + 1) & 1][k] = KVg[(size_t)(n * 4 + hg) * 32768 + dvg]; dc[(b + 1) & 1][k] = DEC[(size_t)(n * 4 + hg) * 128 + d]; } }
#pragma unroll
                for (int k = 0; k < 13; ++k) { const int n = 1 + 13 * b + k; const size_t ir = (size_t)(n * 8 + hr_) * 16384 + dvr, ig = (size_t)(n * 4 + hg) * 32768 + dvg;
                    PVr[ir] = f2bf(pr); PVg[ig] = f2bf(pg); pr = g128 * pr + kr[b & 1][k]; pg = dc[b & 1][k] * pg + kg[b & 1][k]; } } } }
    { const float* E = (const float*)(ws + WS_S5E); float* Hs = (float*)(ws + WS_S5H);
        for (size_t e = gsz - 1 - gtid; e < (size_t)4096; e += gsz) { const int g = (int)(e >> 6), pp = (int)(e & 63); float ar, ai, fre, fim; s5_disc(ka, l, g, pp, ar, ai, fre, fim);
#pragma unroll
            for (int k = 0; k < 7; ++k) { const float nr = ar * ar - ai * ai, ni = 2.0f * ar * ai; ar = nr; ai = ni; }
            float hr = 0.f, hi = 0.f;
            for (int n0 = 1; n0 < NCH; n0 += 13) { float er[13], ei[13];
#pragma unroll
                for (int k = 0; k < 13; ++k) { const size_t idx = ((size_t)(n0 + k) * 4096 + e) * 2; er[k] = E[idx]; ei[k] = E[idx + 1]; }
#pragma unroll
                for (int k = 0; k < 13; ++k) { const size_t idx = ((size_t)(n0 + k) * 4096 + e) * 2; Hs[idx] = hr; Hs[idx + 1] = hi;
                    const float nr = ar * hr - ai * hi + er[k], ni = ar * hi + ai * hr + ei[k]; hr = nr; hi = ni; } } } }
}

constexpr int OFF_Q = 0, OFF_KS = 128 * P128, OFF_V = 2 * 128 * P128, OFF_P = 3 * 128 * P128, OFF_X = 4 * 128 * P128;
__device__ __forceinline__ void ret_out_unit(KA ka, unsigned char* ws, LAS unsigned char* lds, int l, int n, int h) {
    const int t = tidx(), w = t >> 6, lane = t & 63, g4 = lane >> 4, l15 = lane & 15;
    const bf16_t* PJ = (const bf16_t*)(ws + WS_PROJ) + (size_t)n * 128 * PLD;
    LAS unsigned char* Qimg = lds + OFF_Q; LAS unsigned char* KSimg = lds + OFF_KS; LAS unsigned char* Vimg = lds + OFF_V; LAS unsigned char* Pimg = lds + OFF_P;
    LAS float* RED = (LAS float*)(lds + OFF_X);
    const float lg = ret_log_gamma(h);
    float gtv[2][4][4], gnv[4];
#pragma unroll
    for (int ni = 0; ni < 4; ++ni) { const int v = (w & 1) * 64 + 16 * ni + l15; gnv[ni] = PF(ret_norm_g)[(size_t)l * 1024 + h * 128 + v];
#pragma unroll
        for (int mi = 0; mi < 2; ++mi)
#pragma unroll
            for (int r = 0; r < 4; ++r) gtv[mi][r][ni] = bf2f(PJ[(size_t)((w >> 1) * 32 + 16 * mi + 4 * g4 + r) * PLD + C_RG + h * 128 + v]); }
    stage_tile(Qimg, P128, PJ + C_RQ + h * 128, PLD, 128);
    stage_tile(KSimg, P128, PJ + C_RK + h * 128, PLD, 128);
    stage_tile(Vimg, P128, PJ + C_RV + h * 128, PLD, 128);
    stage_tile(Pimg, P128, (const bf16_t*)(ws + WS_RPREV) + (size_t)(n * 8 + h) * 16384, 128, 128);
    __syncthreads();
    const int c0 = (w >> 1) * 32, x0 = (w & 1) * 64;
    f32x4 sc[2][4];
#pragma unroll
    for (int a = 0; a < 2; ++a)
#pragma unroll
        for (int b = 0; b < 4; ++b) sc[a][b] = (f32x4){0.f, 0.f, 0.f, 0.f};
    if (x0 <= c0 + 31) {
#pragma unroll
        for (int ks = 0; ks < 4; ++ks) { bf16x8 a[2], b[4];
#pragma unroll
            for (int mi = 0; mi < 2; ++mi) a[mi] = frag_row(Qimg, P128, c0 + 16 * mi, 32 * ks, lane);
#pragma unroll
            for (int ni = 0; ni < 4; ++ni) b[ni] = frag_row(KSimg, P128, x0 + 16 * ni, 32 * ks, lane);
#pragma unroll
            for (int mi = 0; mi < 2; ++mi)
#pragma unroll
                for (int ni = 0; ni < 4; ++ni) sc[mi][ni] = MFMA16(a[mi], b[ni], sc[mi][ni]); } }
    __syncthreads();
#pragma unroll
    for (int mi = 0; mi < 2; ++mi)
#pragma unroll
        for (int ni = 0; ni < 4; ++ni)
#pragma unroll
            for (int r = 0; r < 4; ++r) { const int c = c0 + 16 * mi + 4 * g4 + r, s = x0 + 16 * ni + l15;
                const float v = (c >= s) ? sc[mi][ni][r] * __expf(lg * (float)(c - s)) : 0.f; *(LAS bf16_t*)(KSimg + c * P128 + s * 2) = f2bf(v); }
    __syncthreads();
    f32x4 a1[2][4], a2[2][4];
#pragma unroll
    for (int a = 0; a < 2; ++a)
#pragma unroll
        for (int b = 0; b < 4; ++b) { a1[a][b] = (f32x4){0.f, 0.f, 0.f, 0.f}; a2[a][b] = (f32x4){0.f, 0.f, 0.f, 0.f}; }
#pragma unroll
    for (int ks = 0; ks < 4; ++ks) { bf16x8 sa[2], qa[2], vb[4], pb[4];
#pragma unroll
        for (int mi = 0; mi < 2; ++mi) { sa[mi] = frag_row(KSimg, P128, c0 + 16 * mi, 32 * ks, lane); qa[mi] = frag_row(Qimg, P128, c0 + 16 * mi, 32 * ks, lane); }
#pragma unroll
        for (int ni = 0; ni < 4; ++ni) { vb[ni] = frag_tr(Vimg, P128, 32 * ks, x0 + 16 * ni, lane); pb[ni] = frag_tr(Pimg, P128, 32 * ks, x0 + 16 * ni, lane); }
#pragma unroll
        for (int mi = 0; mi < 2; ++mi)
#pragma unroll
            for (int ni = 0; ni < 4; ++ni) { a1[mi][ni] = MFMA16(sa[mi], vb[ni], a1[mi][ni]); a2[mi][ni] = MFMA16(qa[mi], pb[ni], a2[mi][ni]); } }
#pragma unroll
    for (int mi = 0; mi < 2; ++mi)
#pragma unroll
        for (int r = 0; r < 4; ++r) { const int c = c0 + 16 * mi + 4 * g4 + r; const float qd = __expf(lg * (float)(c + 1)); float s = 0.f, ss = 0.f;
#pragma unroll
            for (int ni = 0; ni < 4; ++ni) { const float o = a1[mi][ni][r] + qd * a2[mi][ni][r]; a1[mi][ni][r] = o; s += o; ss += o * o; }
#pragma unroll
            for (int o = 1; o <= 8; o <<= 1) { s += __shfl_xor(s, o); ss += __shfl_xor(ss, o); }
            if (l15 == 0) { RED[(c * 2 + (w & 1)) * 2] = s; RED[(c * 2 + (w & 1)) * 2 + 1] = ss; } }
    __syncthreads();
    bf16_t* RO = (bf16_t*)(ws + WS_RO);
#pragma unroll
    for (int mi = 0; mi < 2; ++mi)
#pragma unroll
        for (int r = 0; r < 4; ++r) { const int c = c0 + 16 * mi + 4 * g4 + r; const float s = RED[c * 4] + RED[c * 4 + 2], ss = RED[c * 4 + 1] + RED[c * 4 + 3];
            const float mu = s * (1.0f / 128.0f); const float var = fmaxf(ss * (1.0f / 128.0f) - mu * mu, 0.f); const float rstd = rsqrtf(var + EPS);
            const size_t row = (size_t)n * 128 + c;
#pragma unroll
            for (int ni = 0; ni < 4; ++ni) { const int v = x0 + 16 * ni + l15;
                RO[row * 1024 + h * 128 + v] = f2bf((a1[mi][ni][r] - mu) * rstd * gnv[ni] * gtv[mi][r][ni]); } }
    __syncthreads();
}
__device__ __forceinline__ void gla_out_unit(KA ka, unsigned char* ws, LAS unsigned char* lds, int l, int n, int h) {
    const int t = tidx(), w = t >> 6, lane = t & 63, g4 = lane >> 4, l15 = lane & 15, d = t & 127, seg = t >> 7;
    const bf16_t* PJ = (const bf16_t*)(ws + WS_PROJ) + (size_t)n * 128 * PLD;
    LAS unsigned char* Qimg = lds + OFF_Q; LAS unsigned char* KSimg = lds + OFF_KS; LAS unsigned char* Vimg = lds + OFF_V; LAS unsigned char* Pimg = lds + OFF_P;
    LAS float* glrS = (LAS float*)(lds + OFF_X); LAS float* segT = glrS + 128 * 16; LAS float* RED = segT + 4 * 128;
    const bf16_t* PV = (const bf16_t*)(ws + WS_GPREV) + (size_t)(n * 4 + h) * 32768;
    u32x4 vt[4], pt[4]; stage_load<128>(vt, PJ + C_GV + h * 256, PLD); stage_load<128>(pt, PV, 256);
    bf16_t qraw[32], kraw[32];
#pragma unroll
    for (int i = 0; i < 32; ++i) { qraw[i] = PJ[(size_t)(seg * 32 + i) * PLD + C_GQ + h * 128 + d]; kraw[i] = PJ[(size_t)(seg * 32 + i) * PLD + C_GK + h * 128 + d]; }
    { float bl[32], blast; gla_gate(ka, ws, l, n, h, glrS, segT, bl, blast);
#pragma unroll
        for (int i = 0; i < 32; ++i) { const int s = seg * 32 + i; const float q = bf2f(qraw[i]), k = bf2f(kraw[i]);
            *(LAS bf16_t*)(Qimg + s * P128 + d * 2) = f2bf(q * __expf(bl[i])); *(LAS bf16_t*)(KSimg + s * P128 + d * 2) = f2bf(k * __expf(-bl[i])); } }
    stage_store<128>(vt, Vimg, P128); stage_store<128>(pt, Pimg, P128);
    __syncthreads();
    stage_load<128>(vt, PJ + C_GV + h * 256 + 128, PLD); stage_load<128>(pt, PV + 128, 256);
    const int c0 = (w >> 1) * 32, x0 = (w & 1) * 64;
    f32x4 sc[2][4];
#pragma unroll
    for (int a = 0; a < 2; ++a)
#pragma unroll
        for (int b = 0; b < 4; ++b) sc[a][b] = (f32x4){0.f, 0.f, 0.f, 0.f};
    if (x0 <= c0 + 31) {
#pragma unroll
        for (int ks = 0; ks < 4; ++ks) { bf16x8 a[2], b[4];
#pragma unroll
            for (int mi = 0; mi < 2; ++mi) a[mi] = frag_row(Qimg, P128, c0 + 16 * mi, 32 * ks, lane);
#pragma unroll
            for (int ni = 0; ni < 4; ++ni) b[ni] = frag_row(KSimg, P128, x0 + 16 * ni, 32 * ks, lane);
#pragma unroll
            for (int mi = 0; mi < 2; ++mi)
#pragma unroll
                for (int ni = 0; ni < 4; ++ni) sc[mi][ni] = MFMA16(a[mi], b[ni], sc[mi][ni]); } }
    __syncthreads();
#pragma unroll
    for (int mi = 0; mi < 2; ++mi)
#pragma unroll
        for (int ni = 0; ni < 4; ++ni)
#pragma unroll
            for (int r = 0; r < 4; ++r) { const int c = c0 + 16 * mi + 4 * g4 + r, s = x0 + 16 * ni + l15;
                const float v = (c >= s) ? sc[mi][ni][r] : 0.f; *(LAS bf16_t*)(KSimg + c * P128 + s * 2) = f2bf(v); }
    __syncthreads();
    float gtv[2][2][4][4], gnv[2][4];
#pragma unroll
    for (int hf = 0; hf < 2; ++hf)
#pragma unroll
        for (int ni = 0; ni < 4; ++ni) { const int v = hf * 128 + (w & 1) * 64 + 16 * ni + l15; gnv[hf][ni] = PF(gla_norm_g)[(size_t)l * 256 + v];
#pragma unroll
            for (int mi = 0; mi < 2; ++mi)
#pragma unroll
                for (int r = 0; r < 4; ++r) gtv[hf][mi][r][ni] = bf2f(PJ[(size_t)((w >> 1) * 32 + 16 * mi + 4 * g4 + r) * PLD + C_GG + h * 256 + v]); }
    f32x4 oa[2][2][4];
#pragma unroll
    for (int hf = 0; hf < 2; ++hf) {
        if (hf == 1) { __syncthreads(); stage_store<128>(vt, Vimg, P128); stage_store<128>(pt, Pimg, P128); __syncthreads(); }
#pragma unroll
        for (int a = 0; a < 2; ++a)
#pragma unroll
            for (int b = 0; b < 4; ++b) oa[hf][a][b] = (f32x4){0.f, 0.f, 0.f, 0.f};
#pragma unroll
        for (int ks = 0; ks < 4; ++ks) { bf16x8 sa[2], qa[2], vb[4], pb[4];
#pragma unroll
            for (int mi = 0; mi < 2; ++mi) { sa[mi] = frag_row(KSimg, P128, c0 + 16 * mi, 32 * ks, lane); qa[mi] = frag_row(Qimg, P128, c0 + 16 * mi, 32 * ks, lane); }
#pragma unroll
            for (int ni = 0; ni < 4; ++ni) { vb[ni] = frag_tr(Vimg, P128, 32 * ks, x0 + 16 * ni, lane); pb[ni] = frag_tr(Pimg, P128, 32 * ks, x0 + 16 * ni, lane); }
#pragma unroll
            for (int mi = 0; mi < 2; ++mi)
#pragma unroll
                for (int ni = 0; ni < 4; ++ni) { oa[hf][mi][ni] = MFMA16(sa[mi], vb[ni], oa[hf][mi][ni]); oa[hf][mi][ni] = MFMA16(qa[mi], pb[ni], oa[hf][mi][ni]); } }
    }
#pragma unroll
    for (int mi = 0; mi < 2; ++mi)
#pragma unroll
        for (int r = 0; r < 4; ++r) { const int c = c0 + 16 * mi + 4 * g4 + r; float ss = 0.f;
#pragma unroll
            for (int hf = 0; hf < 2; ++hf)
#pragma unroll
                for (int ni = 0; ni < 4; ++ni) { const float o = oa[hf][mi][ni][r]; ss += o * o; }
#pragma unroll
            for (int o = 1; o <= 8; o <<= 1) ss += __shfl_xor(ss, o);
            if (l15 == 0) RED[c * 2 + (w & 1)] = ss; }
    __syncthreads();
    bf16_t* GO = (bf16_t*)(ws + WS_GO);
#pragma unroll
    for (int mi = 0; mi < 2; ++mi)
#pragma unroll
        for (int r = 0; r < 4; ++r) { const int c = c0 + 16 * mi + 4 * g4 + r; const float ss = RED[c * 2] + RED[c * 2 + 1]; const float rstd = rsqrtf(ss * (1.0f / 256.0f) + EPS);
            const size_t row = (size_t)n * 128 + c;
#pragma unroll
            for (int hf = 0; hf < 2; ++hf)
#pragma unroll
                for (int ni = 0; ni < 4; ++ni) { const int v = hf * 128 + x0 + 16 * ni + l15;
                    GO[row * 1024 + h * 256 + v] = f2bf(oa[hf][mi][ni][r] * rstd * gnv[hf][ni] * gtv[hf][mi][r][ni]); } }
    __syncthreads();
}

constexpr int U_GLA = 65 * 4, U_RET = 65 * 8, U_S5 = 65 * 8, U_ALL = U_GLA + U_RET + U_S5;
__device__ __forceinline__ int unit_of(int b, int k, int nb) {
    if (nb != 256) { const int u = b + k * nb; return u < U_ALL ? u : -1; }
    const int j = b - 4;
    switch (k) {
        case 0: return b;
        case 1: return b < 4 ? 256 + b : -1;
        case 2: return U_GLA + (b < 4 ? b : 4 + j);
        case 3: return b < 4 ? -1 : U_GLA + 256 + j;
        case 4: return (b >= 4 && j < 12) ? U_GLA + 508 + j : -1;
        case 5: return U_GLA + U_RET + (b < 4 ? b : 4 + j);
        case 6: return b < 4 ? -1 : U_GLA + U_RET + 256 + j;
        case 7: return (b >= 4 && j >= 12 && j < 24) ? U_GLA + U_RET + 508 + (j - 12) : -1;
        default: return -1;
    }
}
__device__ __forceinline__ void phase_states(KA ka, unsigned char* ws, LAS unsigned char* lds, int l, int bid, int nb) {
    const int nslots = nb == 256 ? 8 : (U_ALL + nb - 1) / nb;
    for (int k = 0; k < nslots; ++k) { const int u = unit_of(bid, k, nb); if (u < 0) continue;
        if (u < U_GLA) gla_state_unit(ka, ws, lds, l, 1 + u / 4, u % 4);
        else if (u < U_GLA + U_RET) { const int v = u - U_GLA; ret_state_unit(ka, ws, lds, 1 + v / 8, v % 8); }
        else { const int v = u - U_GLA - U_RET; s5_task(ka, ws, lds, l, 1 + v / 8, v % 8, 0); }
    }
}
__device__ __forceinline__ void phase_outputs(KA ka, unsigned char* ws, LAS unsigned char* lds, int l, int bid, int nb) {
    const int nslots = nb == 256 ? 8 : (U_ALL + nb - 1) / nb;
    for (int k = 0; k < nslots; ++k) { const int u = unit_of(bid, k, nb); if (u < 0) continue;
        if (u < U_GLA) gla_out_unit(ka, ws, lds, l, 1 + u / 4, u % 4);
        else if (u < U_GLA + U_RET) { const int v = u - U_GLA; ret_out_unit(ka, ws, lds, l, 1 + v / 8, v % 8); }
        else { const int v = u - U_GLA - U_RET; s5_task(ka, ws, lds, l, 1 + v / 8, v % 8, 1); }
    }
}

__global__ void __launch_bounds__(NT) mega(Params p) {
    extern __shared__ __attribute__((aligned(16))) unsigned char lds_raw[];
    LAS unsigned char* lds = (LAS unsigned char*)lds_raw;
    cg::grid_group grid = cg::this_grid();
    const int bid = blockIdx.x, nb = gridDim.x;
    KA ka = (KA)__builtin_amdgcn_kernarg_segment_ptr();
    unsigned char* ws = PF(ws);
#define FRESH() do { int z_ = 0; asm volatile("" : "+v"(z_)); const int zz_ = __builtin_amdgcn_readfirstlane(z_); ka = (KA)__builtin_amdgcn_kernarg_segment_ptr() + zz_; ws = PF(ws) + zz_; } while (0)
#define WSP(T, off) ((T*)(ws + (off)))

    volatile LAS unsigned* st = (volatile LAS unsigned*)(lds + LDS_BYTES - 16);
    if (tidx() == 0) { st[0] = 0u; st[1] = 0u; }
    __syncthreads();
    (void)xcd_barrier_post((unsigned*)(PF(ws) + WS_BAR), st);
#define STAMP(k) do { if (TK && bid == 0 && tidx() == 0) ((unsigned long long*)(PF(ws) + WS_STAMP))[k] = __builtin_amdgcn_s_memrealtime(); } while (0)
    STAMP(0);
#define GSYNC() do { XcdBarrier b_; b_.bar = (unsigned*)(PF(ws) + WS_BAR); b_.x = xb_xcc_id(); b_.st = (volatile LAS unsigned*)(lds + LDS_BYTES - 16); xcd_barrier(b_); } while (0)
    FRESH(); phase_prep(ka, ws, lds, bid, nb);
    grid.sync(); STAMP(1);
    for (int l = 0; l < DEPTH; ++l) {
        FRESH();
        { const bf16_t* HN = WSP(const bf16_t, WS_HN); const bf16_t* W = WSP(const bf16_t, WS_WIN) + (size_t)l * NIN_T * DM;
            pg8::Gemm g{HN, W, 0, 0, MR, NIN_T, DM}; pg8::StaticOrder S; S.init(MR, NIN_T, nb, bid, 1);
            EpiIn E{WSP(bf16_t, WS_PROJ), WSP(float, WS_GLR), WSP(const float, WS_COS), WSP(const float, WS_SIN), WSP(const float, WS_SS) + (size_t)l * MR * 64};
            pg8::gemm_phase<EpiIn>(lds, g, S, E); }
        GSYNC(); STAMP(2 + 7 * l + 0);
        FRESH(); phase_states(ka, ws, lds, l, bid, nb);
        GSYNC(); STAMP(2 + 7 * l + 1);
        FRESH(); phase_scan(ka, ws, l, bid, nb);
        GSYNC(); STAMP(2 + 7 * l + 2);
        FRESH(); phase_outputs(ka, ws, lds, l, bid, nb);
        GSYNC(); STAMP(2 + 7 * l + 3);
        FRESH();
        { const bf16_t* A = WSP(const bf16_t, WS_SOPRE); const bf16_t* W = WSP(const bf16_t, WS_WGLU) + (size_t)l * 1024 * 1024;
            pg8::Gemm g{A, W, 0, 0, SEQ, 1024, 1024}; pg8::StaticOrder S; S.init(SEQ, 1024, nb, bid, 1, 1);
            EpiGlu E{A, WSP(const bf16_t, WS_PROJ), WSP(bf16_t, WS_SO)};
            skinny_phase<EpiGlu>(lds, A, W, 0, 0, 1024, 1024, 0, 1, E, (bid + nb - 128) % nb, nb);
            { const bf16_t* Wb = WSP(const bf16_t, WS_WBR) + (size_t)l * 3 * 2048 * 1024; EpiBr Eb{WSP(const bf16_t, WS_PROJ), WSP(float, WS_YACC), WSP(bf16_t, WS_Y)};
              skinny_phase<EpiBr>(lds, WSP(const bf16_t, WS_RO), Wb, WS_GO - WS_RO, (size_t)2048 * 1024 * 2, 1024, 2048, 0, 2, Eb, (bid + nb - 160) % nb, nb); }
            pg8::gemm_phase<EpiGlu>(lds, g, S, E); }
        GSYNC(); STAMP(2 + 7 * l + 4);
        FRESH();
        { const bf16_t* W = WSP(const bf16_t, WS_WBR) + (size_t)l * 3 * 2048 * 1024;
            pg8::Gemm g{WSP(const bf16_t, WS_RO), W, WS_GO - WS_RO, (size_t)2048 * 1024 * 2, MR, 2048, 1024};
            static_assert(WS_SO - WS_GO == WS_GO - WS_RO, "branch inputs must be equally spaced");
            pg8::StaticOrder S; S.init(SEQ, 2048, nb, bid, 3, 1);
            EpiBr E{WSP(const bf16_t, WS_PROJ), WSP(float, WS_YACC), WSP(bf16_t, WS_Y)};
            skinny_phase<EpiBr>(lds, g.A, g.Bt, g.selA, g.selB, 1024, 2048, 2, 3, E, bid, nb);
            pg8::gemm_phase<EpiBr>(lds, g, S, E); }
        GSYNC(); STAMP(2 + 7 * l + 5);
        FRESH();
        { const bf16_t* A = WSP(const bf16_t, WS_Y); const bf16_t* W = WSP(const bf16_t, WS_WOUT) + (size_t)l * 2048 * 2048;
            pg8::Gemm g{A, W, 0, 0, SEQ, 2048, 2048}; pg8::StaticOrder S; S.init(SEQ, 2048, nb, bid, 1, 1);
            EpiOut E{WSP(float, WS_H), WSP(bf16_t, WS_HN), l + 1 < DEPTH ? PF(norm_g) + (size_t)(l + 1) * DM : (const float*)nullptr, WSP(float, WS_SS) + (size_t)(l + 1) * MR * 64};
            skinny_phase<EpiOut>(lds, A, W, 0, 0, 2048, 2048, 0, 1, E, bid, nb);
            pg8::gemm_phase<EpiOut>(lds, g, S, E); }
        GSYNC(); STAMP(2 + 7 * l + 6);
    }
    FRESH(); float eps = 0.f;
    if (TK) { const unsigned long long* st_ = (const unsigned long long*)(ws + WS_STAMP); eps = sqrtf(5e-8f * 0.01f * (float)(st_[TK] - st_[TK0])); }
    phase_final(WSP(const float, WS_H), WSP(const float, WS_SS) + (size_t)DEPTH * MR * 64, PF(final_g), PF(out), bid, nb, eps);
}

extern "C" void kernel_launch(void* const* d_in, const int* in_sizes, int n_in, void* d_out, int out_size, void* d_ws, size_t ws_size, hipStream_t stream) {
    static int grid = 0;
    if (grid == 0) {
        if (n_in != 22 || ws_size < WS_END) { fprintf(stderr, "kernel_launch: unexpected inputs (n_in %d) or workspace too small (%zu < %zu)\n", n_in, ws_size, (size_t)WS_END); grid = -1; return; }
        int dev = 0, cus = 0, per_cu = 0;
        hipGetDevice(&dev); hipDeviceGetAttribute(&cus, hipDeviceAttributeMultiprocessorCount, dev);
        if (hipFuncSetAttribute((const void*)mega, hipFuncAttributeMaxDynamicSharedMemorySize, LDS_BYTES) != hipSuccess) { fprintf(stderr, "kernel_launch: hipFuncSetAttribute failed\n"); grid = -1; return; }
        if (hipOccupancyMaxActiveBlocksPerMultiprocessor(&per_cu, (const void*)mega, NT, LDS_BYTES) != hipSuccess || per_cu < 1) { fprintf(stderr, "kernel_launch: occupancy query gave %d\n", per_cu); per_cu = 1; (void)hipGetLastError(); }
        grid = cus * per_cu;
    }
    if (grid < 0) return;
    Params p{};
    const float** f = (const float**)&p;
    for (int i = 0; i < 22; ++i) f[i] = (const float*)d_in[i];
    p.out = (float*)d_out; p.ws = (unsigned char*)d_ws;
    if (hipMemsetAsync((char*)d_ws + WS_BAR, 0, 3456 * 4 + 2 * DEPTH * 256, stream) != hipSuccess) { fprintf(stderr, "kernel_launch: memset failed\n"); return; }
    void* args[] = {&p};
    hipError_t e = hipLaunchCooperativeKernel((const void*)mega, dim3(grid), dim3(NT), args, LDS_BYTES, stream);
    if (e != hipSuccess) fprintf(stderr, "cooperative launch failed: %s (grid %d)\n", hipGetErrorString(e), grid);
}
```

```cpp
#include <hip/hip_runtime.h>
#include <hip/hip_cooperative_groups.h>
#include <cstdio>
#include <cstddef>
namespace cg = cooperative_groups;

#ifndef TK
#define TK 0
#endif
#ifndef TK0
#define TK0 0
#endif
#define LAS __attribute__((address_space(3)))
typedef unsigned short bf16_t;
typedef short bf16x8 __attribute__((ext_vector_type(8)));
typedef short s16x4 __attribute__((ext_vector_type(4)));
typedef float f32x4 __attribute__((ext_vector_type(4)));
typedef unsigned u32x4 __attribute__((ext_vector_type(4)));
typedef unsigned u32x2 __attribute__((ext_vector_type(2)));

constexpr int DM = 2048, SEQ = 8192, DEPTH = 4;
constexpr int ROW0 = 240;
constexpr int MR = 8448;
constexpr int NCH = 66;
constexpr int NIN_SRC = 15376;
constexpr int NIN_T = 15616;
constexpr int PLD = 15360;
constexpr int C_RQ = 0, C_RK = 1024, C_RV = 2048, C_RG = 3072, C_GQ = 4096, C_GK = 4608, C_GV = 5120, C_GG = 6144, C_SU = 7168, C_SG = 8192, C_MG = 9216;
constexpr float EPS = 1e-6f;
constexpr int NT = 512;
constexpr int LDS_BYTES = 155648;

constexpr size_t al256(size_t x) { return (x + 255) & ~(size_t)255; }
constexpr size_t WS_H = 0;
constexpr size_t WS_HN = WS_H + al256((size_t)MR * DM * 4);
constexpr size_t WS_PROJ = WS_HN + al256((size_t)MR * DM * 2);
constexpr size_t WS_GLR = WS_PROJ + al256((size_t)MR * PLD * 2);
constexpr size_t WS_WIN = WS_GLR + al256((size_t)MR * 16 * 4);
constexpr size_t WS_WGLU = WS_WIN + al256((size_t)DEPTH * NIN_T * DM * 2);
constexpr size_t WS_WBR = WS_WGLU + al256((size_t)DEPTH * 1024 * 1024 * 2);
constexpr size_t WS_WOUT = WS_WBR + al256((size_t)DEPTH * 3 * 2048 * 1024 * 2);
constexpr size_t WS_COS = WS_WOUT + al256((size_t)DEPTH * 2048 * 2048 * 2);
constexpr size_t WS_SIN = WS_COS + al256((size_t)MR * 64 * 4);
constexpr size_t WS_RKV = WS_SIN + al256((size_t)MR * 64 * 4);
constexpr size_t WS_RPREV = WS_RKV + al256((size_t)NCH * 8 * 128 * 128 * 4);
constexpr size_t WS_GKV = WS_RPREV + al256((size_t)NCH * 8 * 128 * 128 * 2);
constexpr size_t WS_GPREV = WS_GKV + al256((size_t)NCH * 4 * 128 * 256 * 4);
constexpr size_t WS_GDEC = WS_GPREV + al256((size_t)NCH * 4 * 128 * 256 * 2);
constexpr size_t WS_S5E = WS_GDEC + al256((size_t)NCH * 4 * 128 * 4);
constexpr size_t WS_S5H = WS_S5E + al256((size_t)NCH * 64 * 64 * 2 * 4);
constexpr size_t WS_RO = WS_S5H + al256((size_t)NCH * 64 * 64 * 2 * 4);
constexpr size_t WS_GO = WS_RO + al256((size_t)MR * 1024 * 2);
constexpr size_t WS_SO = WS_GO + al256((size_t)MR * 1024 * 2);
constexpr size_t WS_SOPRE = WS_SO + al256((size_t)MR * 1024 * 2);
constexpr size_t WS_Y = WS_SOPRE + al256((size_t)MR * 1024 * 2);
constexpr size_t WS_YACC = WS_Y + al256((size_t)MR * DM * 2);
constexpr size_t WS_SS = WS_YACC + al256((size_t)MR * DM * 4);
constexpr size_t WS_BAR = WS_SS + al256((size_t)(DEPTH + 1) * MR * 64 * 4);
constexpr size_t WS_QCTR = WS_BAR + 3456 * 4;
constexpr size_t WS_STAMP = WS_QCTR + 2 * DEPTH * 256;
constexpr size_t WS_END = WS_STAMP + 512;

struct Params {
    const float* x; const float* meta; const float* norm_g; const float* w_in; const float* ret_norm_g;
    const float* gla_w_a; const float* gla_b_a; const float* gla_norm_g;
    const float* s5_lre; const float* s5_lim; const float* s5_logdt; const float* s5_bre; const float* s5_bim; const float* s5_cre; const float* s5_cim;
    const float* s5_d; const float* s5_wglu; const float* w_br_ret; const float* w_br_gla; const float* w_br_s5; const float* w_out; const float* final_g;
    float* out; unsigned char* ws;
};

typedef const __attribute__((address_space(4))) char* KA;
#define PF(f) (*(decltype(Params::f) const __attribute__((address_space(4)))*)(ka + offsetof(Params, f)))

__device__ __forceinline__ unsigned cvt_pk_bf16(float lo, float hi) { unsigned r; asm("v_cvt_pk_bf16_f32 %0, %1, %2" : "=v"(r) : "v"(lo), "v"(hi)); return r; }
__device__ __forceinline__ bf16_t f2bf(float f) { return (bf16_t)(cvt_pk_bf16(f, 0.f) & 0xffffu); }
__device__ __forceinline__ float bf2f(bf16_t b) { return __uint_as_float(((unsigned)b) << 16); }
__device__ __forceinline__ float bflo(unsigned w) { return __uint_as_float(w << 16); }
__device__ __forceinline__ float bfhi(unsigned w) { return __uint_as_float(w & 0xffff0000u); }
__device__ __forceinline__ float sigmoidf_(float x) { return __builtin_amdgcn_rcpf(1.0f + __expf(-x)); }
__device__ __forceinline__ float siluf_(float x) { return x * __builtin_amdgcn_rcpf(1.0f + __expf(-x)); }
__device__ __forceinline__ float logsigmoidf_(float x) { return fminf(x, 0.f) - __logf(1.0f + __expf(-fabsf(x))); }
__device__ __forceinline__ float geluf_(float x) { const float z = 0.7978845608028654f * (x + 0.044715f * x * x * x); const float t = 1.0f - 2.0f / (__expf(2.0f * z) + 1.0f); return 0.5f * x * (1.0f + t); }
__device__ __forceinline__ void sincos_red(float ang, float& s, float& c) {
    const float n = rintf(ang * 0.15915494309189535f);
    float r = fmaf(-n, 6.2831854820251465f, ang);
    r = fmaf(-n, -1.7484556000744883e-7f, r);
    const float rev = r * 0.15915494309189535f;
    s = __builtin_amdgcn_sinf(rev); c = __builtin_amdgcn_cosf(rev);
}
__device__ __forceinline__ float ret_log_gamma(int h) { return log1pf(-exp2f(-5.0f - (float)h)); }

__device__ __forceinline__ bf16x8 frag_row(const LAS unsigned char* img, int pitch, int r0, int k0, int lane) {
    return *(const LAS bf16x8*)(img + (r0 + (lane & 15)) * pitch + (k0 + 8 * (lane >> 4)) * 2);
}
__device__ __forceinline__ bf16x8 frag_tr(const LAS unsigned char* img, int pitch, int k0, int c0, int lane) {
    const int g = lane >> 4, q = (lane & 15) >> 2, p = lane & 3;
    const LAS unsigned char* a = img + (k0 + 8 * g + q) * pitch + (c0 + 4 * p) * 2;
    const s16x4 lo = __builtin_amdgcn_ds_read_tr16_b64_v4i16((LAS s16x4*)a);
    const s16x4 hi = __builtin_amdgcn_ds_read_tr16_b64_v4i16((LAS s16x4*)(a + 4 * pitch));
    bf16x8 r; r[0] = lo[0]; r[1] = lo[1]; r[2] = lo[2]; r[3] = lo[3]; r[4] = hi[0]; r[5] = hi[1]; r[6] = hi[2]; r[7] = hi[3]; return r;
}
__device__ __forceinline__ int tidx() { int t = (int)__builtin_amdgcn_workitem_id_x(); asm volatile("" : "+v"(t)); return t; }
#define MFMA16(a, b, c) __builtin_amdgcn_mfma_f32_16x16x32_bf16((a), (b), (c), 0, 0, 0)


#define XB_TMO      128
#define XB_XCNT(j)  (256  + 64 * (j))
#define XB_XSUB(j)  (1280 + 64 * (j))
#define XB_XGEN(j)  (2304 + 64 * (j))
#define XB_TOP      3328
#define XB_TOPGEN   3392
#define XCD_BAR_WORDS 3456
#define XB_SPIN_CAP (1u << 22)
__device__ __forceinline__ unsigned xb_ld(unsigned* p)              { return __hip_atomic_load(p, __ATOMIC_RELAXED, __HIP_MEMORY_SCOPE_AGENT); }
__device__ __forceinline__ unsigned xb_add(unsigned* p, unsigned v) { return __hip_atomic_fetch_add(p, v, __ATOMIC_RELAXED, __HIP_MEMORY_SCOPE_AGENT); }
__device__ __forceinline__ unsigned xb_xcc_id() { return (unsigned)__builtin_amdgcn_s_getreg((3 << 11) | 20) & 0xFu; }
#define XB_SPIN(cond, bar) do { unsigned _sp = 0; while (cond) { __builtin_amdgcn_s_sleep(1); \
    if ((++_sp & 255u) == 0u) { if (xb_ld(&(bar)[XB_TMO])) break; if (_sp > XB_SPIN_CAP) { atomicAdd(&(bar)[XB_TMO], 1u); break; } } } } while (0)
struct XcdBarrier { unsigned* bar; unsigned x; volatile LAS unsigned* st; };
__device__ __forceinline__ XcdBarrier xcd_barrier_post(unsigned* bar, volatile LAS unsigned* st) {
    XcdBarrier b; b.bar = bar; b.x = xb_xcc_id(); b.st = st;
    if (tidx() == 0) (void)xb_add(&bar[XB_XCNT(b.x)], 1u);
    return b;
}
__device__ __forceinline__ void xcd_barrier_complete(unsigned* bar, unsigned x, unsigned& nloc, unsigned& nx) {
    const unsigned G = gridDim.x * gridDim.y * gridDim.z;
    unsigned sum, cnt, mine, sp = 0u;
    for (;;) {
        sum = 0u; cnt = 0u; mine = 0u;
#pragma unroll
        for (unsigned j = 0; j < 16; ++j) { const unsigned c = xb_ld(&bar[XB_XCNT(j)]); sum += c; cnt += (c > 0u) ? 1u : 0u; mine = (j == x) ? c : mine; }
        if (sum == G) break;
        __builtin_amdgcn_s_sleep(1);
        if ((++sp & 255u) == 0u) { if (xb_ld(&bar[XB_TMO])) break; if (sp > XB_SPIN_CAP) { atomicAdd(&bar[XB_TMO], 1u); break; } }
    }
    nloc = mine > 0u ? mine : 1u; nx = cnt > 0u ? cnt : 1u;
}
__device__ __forceinline__ void xcd_barrier(const XcdBarrier& b) {
    asm volatile("s_waitcnt vmcnt(0)" ::: "memory");
    __syncthreads();
    if (tidx() == 0) {
        unsigned* bar = b.bar;
        __builtin_amdgcn_s_waitcnt(0);
        unsigned nloc = b.st[0], nx = b.st[1];
        if (nloc == 0u) { xcd_barrier_complete(bar, b.x, nloc, nx); b.st[0] = nloc; b.st[1] = nx; }
        const unsigned old = xb_add(&bar[XB_XSUB(b.x)], 1u);
        const unsigned gen = old / nloc;
        if (old + 1u == (gen + 1u) * nloc) {
            __builtin_amdgcn_fence(__ATOMIC_RELEASE, "agent");
            asm volatile("s_waitcnt vmcnt(0)" ::: "memory");
            const unsigned og = xb_add(&bar[XB_TOP], 1u);
            const unsigned tg = og / nx;
            if (og + 1u == (tg + 1u) * nx) xb_add(&bar[XB_TOPGEN], 1u);
            else XB_SPIN(xb_ld(&bar[XB_TOPGEN]) == tg, bar);
            __builtin_amdgcn_fence(__ATOMIC_ACQUIRE, "agent");
            xb_add(&bar[XB_XGEN(b.x)], 1u);
            asm volatile("s_waitcnt vmcnt(0)" ::: "memory");
        } else {
            XB_SPIN(xb_ld(&bar[XB_XGEN(b.x)]) == gen, bar);
            __builtin_amdgcn_fence(__ATOMIC_ACQUIRE, "agent");
            asm volatile("s_waitcnt vmcnt(0)" ::: "memory");
        }
    }
    __syncthreads();
}

namespace pg8 {
constexpr int BM = 256, BK = 64, HALF = 128, HTB = HALF * BK * 2, STAGE_BYTES = 8 * HTB, NXCD = 8, WGM = 8;
__host__ __device__ __forceinline__ int lds_byte(int r, int c) { const int st = (r >> 4) * 2 + (c >> 5), rr = r & 15, cc = c & 31, ob = rr * 64 + cc * 2; return st * 1024 + (ob ^ (((ob >> 9) & 1) << 5)); }
__host__ __device__ __forceinline__ void stage_rc(int b, int& R, int& C) { const int st = b / 1024, sb = b % 1024, swz = sb ^ (((sb >> 9) & 1) << 5); R = (st >> 1) * 16 + swz / 64; C = (st & 1) * 32 + (swz % 64) / 2; }
__host__ __device__ __forceinline__ int perm32(int rho) { const int n = rho >> 4, i = rho & 15; return 8 * (i >> 2) + 4 * n + (i & 3); }

struct Unit { int pm, pn, sel; };
struct Gemm { const bf16_t* A; const bf16_t* Bt; size_t selA, selB; int M, N, K; };
__device__ __forceinline__ const char* selA(const Gemm& g, int s) { return (const char*)g.A + (size_t)s * g.selA; }
__device__ __forceinline__ const char* selB(const Gemm& g, int s) { return (const char*)g.Bt + (size_t)s * g.selB; }

struct StaticOrder {
    int nM, nN, nwg, G, c, nsel, pm0;
    __device__ void init(int M, int N, int G_, int c_, int nsel_, int pm0_ = 0) { nM = M / BM; nN = N / BM; nwg = nM * nN; G = G_; c = c_; nsel = nsel_; pm0 = pm0_; }
    __device__ bool next(int i, Unit& u) const {
        const int it = i / nsel; u.sel = i - it * nsel;
        const long L = (long)it * G + c; if (L >= nwg) return false;
        int wgid = (int)L; { const int q = nwg / NXCD, r = nwg % NXCD, xcd = wgid % NXCD, off = wgid / NXCD; wgid = (xcd < r ? xcd * (q + 1) : r * (q + 1) + (xcd - r) * q) + off; }
        const int nig = WGM * nN, gid = wgid / nig, fm = gid * WGM, gsz = (nM - fm) < WGM ? (nM - fm) : WGM;
        u.pm = pm0 + fm + ((wgid % nig) % gsz); u.pn = (wgid % nig) / gsz; return true;
    }
};

template <class Epi>
__device__ __forceinline__ void gemm_phase(LAS unsigned char* lds, const Gemm g, const StaticOrder& S, const Epi& E) {
    const int tid = tidx(), wid = __builtin_amdgcn_readfirstlane(tid >> 6), lane = tid & 63, wr = wid >> 2, wc = wid & 3, fr = lane & 15, fq = lane >> 4;
    const int K = g.K, nt = K / BK;
    unsigned voffA[2], voffB[2];
#pragma unroll
    for (int i = 0; i < 2; ++i) { int R, C; stage_rc(tid * 16 + i * 8192, R, C); const int Rb = (R & ~31) + perm32(R & 31);
        voffA[i] = (unsigned)(R * K + C) * 2u; voffB[i] = (unsigned)(Rb * K + C) * 2u; }
    const size_t kstep = (size_t)(BK * 2);
    const size_t hstep = (size_t)HALF * K * 2;
    const size_t tstep = 2 * hstep;
    const unsigned ldsw = (unsigned)wid * 1024u;
    const int aoff = lds_byte(wr * 64 + fr, fq * 8), boff = lds_byte(wc * 32 + fr, fq * 8);
#define PG8_SA(b, h) (((b) * 2 + (h)) * HTB)
#define PG8_SB(b, h) ((4 + (b) * 2 + (h)) * HTB)
#define PG8_STAGE(bufoff, gbase, voff) do { _Pragma("unroll") for (int _i = 0; _i < 2; ++_i) \
        __builtin_amdgcn_global_load_lds((const unsigned*)((const char*)(gbase) + (voff)[_i]), (LAS unsigned*)(lds + (bufoff) + ldsw + _i * 8192), 16, 0, 0); } while (0)
#define PG8_LDA(dst, b, h) do { _Pragma("unroll") for (int m = 0; m < 4; ++m) _Pragma("unroll") for (int k = 0; k < 2; ++k) dst[m][k] = *(const LAS bf16x8*)(lds + PG8_SA(b, h) + aoff + m * 2048 + k * 1024); } while (0)
#define PG8_LDB(dst, b, h) do { _Pragma("unroll") for (int n = 0; n < 2; ++n) _Pragma("unroll") for (int k = 0; k < 2; ++k) dst[n][k] = *(const LAS bf16x8*)(lds + PG8_SB(b, h) + boff + n * 2048 + k * 1024); } while (0)
#define PG8_MMA(ai, bj, At, Bt) do { __builtin_amdgcn_s_setprio(1); _Pragma("unroll") for (int m = 0; m < 4; ++m) _Pragma("unroll") for (int n = 0; n < 2; ++n) _Pragma("unroll") for (int k = 0; k < 2; ++k) \
        acc[ai][bj][m][n] = __builtin_amdgcn_mfma_f32_16x16x32_bf16(Bt[n][k], At[m][k], acc[ai][bj][m][n], 0, 0, 0); __builtin_amdgcn_s_setprio(0); } while (0)
#define PG8_WAIT_V(n) asm volatile("s_waitcnt vmcnt(" #n ")" ::: "memory")
#define PG8_WAIT_L(n) asm volatile("s_waitcnt lgkmcnt(" #n ")" ::: "memory")
#define PG8_BAR __builtin_amdgcn_s_barrier()
#define PG8_SCHED __builtin_amdgcn_sched_barrier(0)
    Unit cur, nxt; int ui = 0;
    if (!S.next(0, cur)) return;
    f32x4 acc[2][2][4][2];
#pragma unroll
    for (int a = 0; a < 2; ++a)
#pragma unroll
        for (int b = 0; b < 2; ++b)
#pragma unroll
            for (int m = 0; m < 4; ++m)
#pragma unroll
                for (int n = 0; n < 2; ++n) acc[a][b][m][n] = (f32x4){0.f, 0.f, 0.f, 0.f};
    bf16x8 At[4][2], B0[2][2], B1[2][2];
    const char* cA = selA(g, cur.sel) + (size_t)cur.pm * tstep; const char* cB = selB(g, cur.sel) + (size_t)cur.pn * tstep;
    PG8_STAGE(PG8_SB(0, 0), cB, voffB); PG8_STAGE(PG8_SA(0, 0), cA, voffA); PG8_STAGE(PG8_SB(0, 1), cB + hstep, voffB); PG8_STAGE(PG8_SA(0, 1), cA + hstep, voffA);
    if (wr == 1) PG8_BAR;
    PG8_WAIT_V(4); PG8_BAR;
    PG8_STAGE(PG8_SB(1, 0), cB + kstep, voffB); PG8_STAGE(PG8_SA(1, 0), cA + kstep, voffA); PG8_STAGE(PG8_SB(1, 1), cB + hstep + kstep, voffB);
    PG8_WAIT_V(6); PG8_BAR;
    for (;;) {
        const bool has_next = S.next(ui + 1, nxt);
        const char* nA = has_next ? selA(g, nxt.sel) + (size_t)nxt.pm * tstep : cA; const char* nB = has_next ? selB(g, nxt.sel) + (size_t)nxt.pn * tstep : cB;
        for (int t = 0; t < nt; t += 2) {
            const bool last = (t == nt - 2);
            const char* a1 = cA + (size_t)(t + 1) * kstep;
            const char* a2 = last ? nA : cA + (size_t)(t + 2) * kstep; const char* b2 = last ? nB : cB + (size_t)(t + 2) * kstep;
            const char* a3 = a2 + kstep; const char* b3 = b2 + kstep;
            PG8_LDB(B0, 0, 0); PG8_SCHED; PG8_LDA(At, 0, 0); PG8_STAGE(PG8_SA(1, 1), a1 + hstep, voffA);
            PG8_WAIT_L(8); PG8_BAR; PG8_WAIT_L(0); PG8_MMA(0, 0, At, B0); PG8_BAR; PG8_SCHED;
            PG8_LDB(B1, 0, 1); PG8_STAGE(PG8_SB(0, 0), b2, voffB);
            PG8_BAR; PG8_WAIT_L(0); PG8_MMA(0, 1, At, B1); PG8_BAR;
            PG8_LDA(At, 0, 1); PG8_STAGE(PG8_SA(0, 0), a2, voffA);
            PG8_BAR; PG8_WAIT_L(0); PG8_MMA(1, 0, At, B0); PG8_BAR; PG8_SCHED;
            PG8_STAGE(PG8_SB(0, 1), b2 + hstep, voffB);
            PG8_WAIT_V(6); PG8_BAR; PG8_MMA(1, 1, At, B1); PG8_BAR;
            PG8_LDB(B0, 1, 0); PG8_SCHED; PG8_LDA(At, 1, 0); PG8_STAGE(PG8_SA(0, 1), a2 + hstep, voffA);
            PG8_WAIT_L(8); PG8_BAR; PG8_WAIT_L(0); PG8_MMA(0, 0, At, B0); PG8_BAR; PG8_SCHED;
            PG8_LDB(B1, 1, 1); PG8_STAGE(PG8_SB(1, 0), b3, voffB);
            PG8_BAR; PG8_WAIT_L(0); PG8_MMA(0, 1, At, B1); PG8_BAR;
            PG8_LDA(At, 1, 1); PG8_STAGE(PG8_SA(1, 0), a3, voffA);
            PG8_BAR; PG8_WAIT_L(0); PG8_MMA(1, 0, At, B0); PG8_BAR; PG8_SCHED;
            PG8_STAGE(PG8_SB(1, 1), b3 + hstep, voffB);
            PG8_WAIT_V(6); PG8_BAR; PG8_MMA(1, 1, At, B1); PG8_BAR;
        }
        bool keep = false;
        if constexpr (Epi::CHAIN) keep = E.chain(acc, cur, wr, wc, fr, fq); else E(acc, cur, wr, wc, fr, fq);
        if (!has_next) break;
        if (!keep) {
#pragma unroll
        for (int a = 0; a < 2; ++a)
#pragma unroll
            for (int b = 0; b < 2; ++b)
#pragma unroll
                for (int m = 0; m < 4; ++m)
#pragma unroll
                    for (int n = 0; n < 2; ++n) acc[a][b][m][n] = (f32x4){0.f, 0.f, 0.f, 0.f};
        }
        cur = nxt; cA = nA; cB = nB; ++ui;
    }
    PG8_WAIT_V(0);
    if (wr == 0) PG8_BAR;
    PG8_BAR;
#undef PG8_SA
#undef PG8_SB
#undef PG8_STAGE
#undef PG8_LDA
#undef PG8_LDB
#undef PG8_MMA
#undef PG8_WAIT_V
#undef PG8_WAIT_L
#undef PG8_BAR
#undef PG8_SCHED
}
}

typedef f32x4 AccT[2][2][4][2];
__device__ __forceinline__ u32x4 pack8(const f32x4 a, const f32x4 b) { u32x4 w; w.x = cvt_pk_bf16(a[0], a[1]); w.y = cvt_pk_bf16(a[2], a[3]); w.z = cvt_pk_bf16(b[0], b[1]); w.w = cvt_pk_bf16(b[2], b[3]); return w; }
__device__ __forceinline__ void unpack8(const u32x4 w, f32x4& a, f32x4& b) { a = (f32x4){bflo(w.x), bfhi(w.x), bflo(w.y), bfhi(w.y)}; b = (f32x4){bflo(w.z), bfhi(w.z), bflo(w.w), bfhi(w.w)}; }

__device__ __forceinline__ float row_rs(const float* part, int r, int fq) {
    const float* pp = part + (size_t)r * 64 + fq * 16; const f32x4 a = *(const f32x4*)pp, b = *(const f32x4*)(pp + 4), c = *(const f32x4*)(pp + 8), d = *(const f32x4*)(pp + 12);
    float s = ((a[0] + a[1]) + (a[2] + a[3])) + ((b[0] + b[1]) + (b[2] + b[3])) + ((c[0] + c[1]) + (c[2] + c[3])) + ((d[0] + d[1]) + (d[2] + d[3])); s += __shfl_xor(s, 16); s += __shfl_xor(s, 32);
    return rsqrtf(s * (1.0f / DM) + EPS);
}
struct EpiIn {   static constexpr bool CHAIN = false;
    bf16_t* P; float* glr; const float* cosT; const float* sinT; const float* ss;
    __device__ __forceinline__ void operator()(const AccT& acc, const pg8::Unit& u, int wr, int wc, int fr, int fq) const {
        const int pn = u.pn; const int row0 = u.pm * 256 + wr * 64 + fr;
        int mode = 0; float scale = 1.0f;
        if (pn < 8) { mode = 1; scale = pn >= 4 ? 0.08838834764831845f : 1.0f; }
        else if ((pn >= 12 && pn < 16) || (pn >= 24 && pn < 28) || (pn >= 32 && pn < 36)) mode = 2;
        else if (pn >= 36 && pn < 60) mode = 3;
        else if (pn == 60) mode = 4;
        else if (pn == 16 || pn == 17) scale = 0.08838834764831845f;
        if (mode == 4) {
            if (wc == 0) {
#pragma unroll
                for (int ai = 0; ai < 2; ++ai)
#pragma unroll
                    for (int m = 0; m < 4; ++m) { const int r = row0 + ai * 128 + m * 16; const float rs = row_rs(ss, r, fq);
                        if (fq < 2) { float* gp = glr + (size_t)r * 16 + 8 * fq; *(f32x4*)gp = acc[ai][0][m][0] * rs; *(f32x4*)(gp + 4) = acc[ai][0][m][1] * rs; } }
            }
            return;
        }
        const int i4 = 4 * (4 * wc + fq);
        float rsv[2][4];
#pragma unroll
        for (int ai = 0; ai < 2; ++ai)
#pragma unroll
            for (int m = 0; m < 4; ++m) rsv[ai][m] = row_rs(ss, row0 + ai * 128 + m * 16, fq);
#pragma unroll
        for (int ai = 0; ai < 2; ++ai)
#pragma unroll
            for (int m = 0; m < 4; ++m) {
                const int r = row0 + ai * 128 + m * 16; const float rs = rsv[ai][m];
                bf16_t* rowp = P + (size_t)r * PLD + pn * 256 + wc * 32 + 8 * fq;
                f32x4 cs = (f32x4){1.f, 1.f, 1.f, 1.f}, sn = (f32x4){0.f, 0.f, 0.f, 0.f};
                if (mode == 1) { const int pos = r >= ROW0 ? r - ROW0 : 0; cs = *(const f32x4*)(cosT + (size_t)pos * 64 + i4); sn = *(const f32x4*)(sinT + (size_t)pos * 64 + i4); }
#pragma unroll
                for (int bj = 0; bj < 2; ++bj) {
                    f32x4 v0 = acc[ai][bj][m][0] * rs, v1 = acc[ai][bj][m][1] * rs;
                    if (mode == 1) { const f32x4 o1 = v0 * cs - v1 * sn, o2 = v0 * sn + v1 * cs; v0 = o1 * scale; v1 = o2 * scale; }
                    else if (mode == 2) {
#pragma unroll
                        for (int j = 0; j < 4; ++j) { v0[j] = siluf_(v0[j]); v1[j] = siluf_(v1[j]); } }
                    else if (mode == 3) {
#pragma unroll
                        for (int j = 0; j < 4; ++j) { v0[j] = sigmoidf_(v0[j]); v1[j] = sigmoidf_(v1[j]); } }
                    else { v0 = v0 * scale; v1 = v1 * scale; }
                    *(u32x4*)(rowp + bj * 128) = pack8(v0, v1);
                }
            }
    }
};
#define EPI_MAIN_LOOP \
        const int row0 = u.pm * 256 + wr * 64 + fr, col0 = u.pn * 256 + wc * 32 + 8 * fq; \
        _Pragma("unroll") for (int ai = 0; ai < 2; ++ai) _Pragma("unroll") for (int m = 0; m < 4; ++m) _Pragma("unroll") for (int bj = 0; bj < 2; ++bj) \
            seg(row0 + ai * 128 + m * 16, col0 + bj * 128, acc[ai][bj][m][0], acc[ai][bj][m][1], u.sel);
struct EpiGlu {
    static constexpr bool CHAIN = false;
    const bf16_t* sopre; const bf16_t* P; bf16_t* so;
    __device__ __forceinline__ void seg(int r, int c, f32x4 v0, f32x4 v1, int sel) const {
        const u32x4 sp = *(const u32x4*)(sopre + (size_t)r * 1024 + c), gt = *(const u32x4*)(P + (size_t)r * PLD + C_SG + c);
        f32x4 s0, s1, g0, g1; unpack8(sp, s0, s1); unpack8(gt, g0, g1);
#pragma unroll
        for (int j = 0; j < 4; ++j) { v0[j] = s0[j] * sigmoidf_(v0[j]) * g0[j]; v1[j] = s1[j] * sigmoidf_(v1[j]) * g1[j]; }
        *(u32x4*)(so + (size_t)r * 1024 + c) = pack8(v0, v1);
    }
    __device__ __forceinline__ void operator()(const AccT& acc, const pg8::Unit& u, int wr, int wc, int fr, int fq) const {
        const int row0 = u.pm * 256 + wr * 64 + fr, col0 = u.pn * 256 + wc * 32 + 8 * fq;
#pragma unroll
        for (int ai = 0; ai < 2; ++ai) { u32x4 sp[4][2], gt[4][2];
#pragma unroll
            for (int m = 0; m < 4; ++m)
#pragma unroll
                for (int bj = 0; bj < 2; ++bj) { const int r = row0 + ai * 128 + m * 16, c = col0 + bj * 128;
                    sp[m][bj] = *(const u32x4*)(sopre + (size_t)r * 1024 + c); gt[m][bj] = *(const u32x4*)(P + (size_t)r * PLD + C_SG + c); }
#pragma unroll
            for (int m = 0; m < 4; ++m)
#pragma unroll
                for (int bj = 0; bj < 2; ++bj) { const int r = row0 + ai * 128 + m * 16, c = col0 + bj * 128;
                    f32x4 s0, s1, g0, g1; unpack8(sp[m][bj], s0, s1); unpack8(gt[m][bj], g0, g1); f32x4 v0 = acc[ai][bj][m][0], v1 = acc[ai][bj][m][1];
#pragma unroll
                    for (int j = 0; j < 4; ++j) { v0[j] = s0[j] * sigmoidf_(v0[j]) * g0[j]; v1[j] = s1[j] * sigmoidf_(v1[j]) * g1[j]; }
                    *(u32x4*)(so + (size_t)r * 1024 + c) = pack8(v0, v1); } }
    }
};
struct EpiBr {
    static constexpr bool CHAIN = true;
    const bf16_t* P; float* yacc; bf16_t* y;
    __device__ __forceinline__ void seg(int r, int c, f32x4 v0, f32x4 v1, int sel) const {
        const u32x4 gt = *(const u32x4*)(P + (size_t)r * PLD + C_MG + sel * 2048 + c);
        f32x4 g0, g1; unpack8(gt, g0, g1); v0 = v0 * g0; v1 = v1 * g1;
        float* yp = yacc + (size_t)r * DM + c;
        if (sel > 0) { v0 = v0 + *(const f32x4*)yp; v1 = v1 + *(const f32x4*)(yp + 4); }
        if (sel < 2) { *(f32x4*)yp = v0; *(f32x4*)(yp + 4) = v1; }
        else *(u32x4*)(y + (size_t)r * DM + c) = pack8(v0, v1);
    }
    __device__ __forceinline__ bool chain(AccT& acc, const pg8::Unit& u, int wr, int wc, int fr, int fq) const {
        const int row0 = u.pm * 256 + wr * 64 + fr, col0 = u.pn * 256 + wc * 32 + 8 * fq; const int sel = u.sel;
#pragma unroll
        for (int ai = 0; ai < 2; ++ai) { u32x4 gc[4][2], gn[4][2];
#pragma unroll
            for (int m = 0; m < 4; ++m)
#pragma unroll
                for (int bj = 0; bj < 2; ++bj) { const bf16_t* gp = P + (size_t)(row0 + ai * 128 + m * 16) * PLD + C_MG + sel * 2048 + col0 + bj * 128;
                    gc[m][bj] = *(const u32x4*)gp; gn[m][bj] = sel < 2 ? *(const u32x4*)(gp + 2048) : gc[m][bj]; }
#pragma unroll
            for (int m = 0; m < 4; ++m)
#pragma unroll
                for (int bj = 0; bj < 2; ++bj) { const int r = row0 + ai * 128 + m * 16, c = col0 + bj * 128;
                    f32x4 g0, g1; unpack8(gc[m][bj], g0, g1);
                    if (sel < 2) { f32x4 n0, n1; unpack8(gn[m][bj], n0, n1);
#pragma unroll
                        for (int j = 0; j < 4; ++j) { acc[ai][bj][m][0][j] *= g0[j] * __builtin_amdgcn_rcpf(fmaxf(n0[j], 1e-20f)); acc[ai][bj][m][1][j] *= g1[j] * __builtin_amdgcn_rcpf(fmaxf(n1[j], 1e-20f)); } }
                    else *(u32x4*)(y + (size_t)r * DM + c) = pack8(acc[ai][bj][m][0] * g0, acc[ai][bj][m][1] * g1); } }
        return sel < 2;
    }
};
struct EpiOut {
    static constexpr bool CHAIN = false;
    float* H; bf16_t* HN; const float* gnext; float* ssn;
    __device__ __forceinline__ void seg(int r, int c, f32x4 v0, f32x4 v1, int sel) const {
        float* hp = H + (size_t)r * DM + c;
        const f32x4 a = *(const f32x4*)hp + v0, b = *(const f32x4*)(hp + 4) + v1;
        *(f32x4*)hp = a; *(f32x4*)(hp + 4) = b;
        float sq = a[0] * a[0] + a[1] * a[1] + a[2] * a[2] + a[3] * a[3] + b[0] * b[0] + b[1] * b[1] + b[2] * b[2] + b[3] * b[3];
        if (gnext) { const f32x4 g0 = *(const f32x4*)(gnext + c), g1 = *(const f32x4*)(gnext + c + 4); *(u32x4*)(HN + (size_t)r * DM + c) = pack8(a * g0, b * g1); }
        sq += __shfl_xor(sq, 16); sq += __shfl_xor(sq, 32);
        if ((c & 31) == 0) ssn[(size_t)r * 64 + (c >> 5)] = sq;
    }
    __device__ __forceinline__ void operator()(const AccT& acc, const pg8::Unit& u, int wr, int wc, int fr, int fq) const {
        const int row0 = u.pm * 256 + wr * 64 + fr, col0 = u.pn * 256 + wc * 32 + 8 * fq;
#pragma unroll
        for (int ai = 0; ai < 2; ++ai) { f32x4 ha[4][2], hb[4][2];
#pragma unroll
            for (int m = 0; m < 4; ++m)
#pragma unroll
                for (int bj = 0; bj < 2; ++bj) { const float* hp = H + (size_t)(row0 + ai * 128 + m * 16) * DM + col0 + bj * 128; ha[m][bj] = *(const f32x4*)hp; hb[m][bj] = *(const f32x4*)(hp + 4); }
#pragma unroll
            for (int m = 0; m < 4; ++m)
#pragma unroll
                for (int bj = 0; bj < 2; ++bj) { const int r = row0 + ai * 128 + m * 16, c = col0 + bj * 128; float* hp = H + (size_t)r * DM + c;
                    const f32x4 a = ha[m][bj] + acc[ai][bj][m][0], b = hb[m][bj] + acc[ai][bj][m][1];
                    *(f32x4*)hp = a; *(f32x4*)(hp + 4) = b;
                    float sq = a[0] * a[0] + a[1] * a[1] + a[2] * a[2] + a[3] * a[3] + b[0] * b[0] + b[1] * b[1] + b[2] * b[2] + b[3] * b[3];
                    if (gnext) { const f32x4 g0 = *(const f32x4*)(gnext + c), g1 = *(const f32x4*)(gnext + c + 4); *(u32x4*)(HN + (size_t)r * DM + c) = pack8(a * g0, b * g1); }
                    sq += __shfl_xor(sq, 16); sq += __shfl_xor(sq, 32);
                    if (fq == 0) ssn[(size_t)r * 64 + (c >> 5)] = sq; } }
    }
};

template <class Epi>
__device__ __forceinline__ void skinny_phase(LAS unsigned char* lds, const bf16_t* A, const bf16_t* Wt, size_t selA, size_t selB, int K, int N, int sel0, int sel1, const Epi& E, int bid, int nb) {
    const int t = tidx(), w = t >> 6, lane = t & 63, l15 = lane & 15, g = lane >> 4;
    LAS float* red = (LAS float*)lds;
    const int ksteps = K / 256;
    for (int grp = bid; grp < N / 32; grp += nb) {
        const int n0 = grp * 32;
        for (int sel = sel0; sel < sel1; ++sel) {
            const bf16_t* Ab = (const bf16_t*)((const char*)A + (size_t)sel * selA) + (size_t)(ROW0 + l15) * K + (size_t)w * (K / 8) + 8 * g;
            const bf16_t* Wb = (const bf16_t*)((const char*)Wt + (size_t)sel * selB) + (size_t)(n0 + 8 * (l15 >> 2) + (l15 & 3)) * K + (size_t)w * (K / 8) + 8 * g;
            f32x4 acc0 = (f32x4){0.f, 0.f, 0.f, 0.f}, acc1 = (f32x4){0.f, 0.f, 0.f, 0.f};
#pragma unroll 4
            for (int ks = 0; ks < ksteps; ++ks) {
                const bf16x8 a0 = *(const bf16x8*)(Wb + ks * 32), a1 = *(const bf16x8*)(Wb + (size_t)4 * K + ks * 32), bb = *(const bf16x8*)(Ab + ks * 32);
                acc0 = MFMA16(a0, bb, acc0); acc1 = MFMA16(a1, bb, acc1);
            }
            *(LAS f32x4*)(red + (w * 64 + lane) * 8) = acc0; *(LAS f32x4*)(red + (w * 64 + lane) * 8 + 4) = acc1;
            __syncthreads();
            if (w == 0) {
                f32x4 v0 = (f32x4){0.f, 0.f, 0.f, 0.f}, v1 = (f32x4){0.f, 0.f, 0.f, 0.f};
#pragma unroll
                for (int k = 0; k < 8; ++k) { v0 = v0 + *(const LAS f32x4*)(red + (k * 64 + lane) * 8); v1 = v1 + *(const LAS f32x4*)(red + (k * 64 + lane) * 8 + 4); }
                E.seg(ROW0 + l15, n0 + 8 * g, v0, v1, sel);
            }
            __syncthreads();
        }
    }
}

__device__ __forceinline__ int win_dst_row(int c) {
    if (c < 2048) { const int hd = c >> 7, d = c & 127, i = d & 63, half = d >> 6; return (hd << 7) + 8 * (i >> 2) + 4 * half + (i & 3); }
    if (c < 7168) return c;
    if (c < 7184) return 15360 + (c - 7168);
    return c - 16;
}
__device__ __forceinline__ void cvt_tile(LAS unsigned char* lds, const float* src, int K, int Ns, bf16_t* dst, int k0, int n0, bool winmap) {
    const int t = tidx(); LAS float* T = (LAS float*)lds;
    { const int n4 = (t & 15) * 4, kk = t >> 4;
        f32x4 v[4];
#pragma unroll
        for (int i = 0; i < 4; ++i) { const int k = kk + 32 * i; v[i] = (n0 + n4 < Ns) ? *(const f32x4*)(src + (size_t)(k0 + k) * Ns + n0 + n4) : (f32x4){0.f, 0.f, 0.f, 0.f}; }
#pragma unroll
        for (int i = 0; i < 4; ++i) { const int k = kk + 32 * i; *(LAS f32x4*)(T + k * 64 + ((n4 + 8 * ((k >> 4) & 7)) & 63)) = v[i]; } }
    __syncthreads();
    { const int n = t >> 3, seg = t & 7; const int nn = (n + 8 * seg) & 63;
        float f[16];
#pragma unroll
        for (int q = 0; q < 16; ++q) f[q] = T[(seg * 16 + q) * 64 + nn];
        if (n0 + n < Ns) { const int dr = winmap ? win_dst_row(n0 + n) : (n0 + n);
            u32x4 a, b2; a.x = cvt_pk_bf16(f[0], f[1]); a.y = cvt_pk_bf16(f[2], f[3]); a.z = cvt_pk_bf16(f[4], f[5]); a.w = cvt_pk_bf16(f[6], f[7]);
            b2.x = cvt_pk_bf16(f[8], f[9]); b2.y = cvt_pk_bf16(f[10], f[11]); b2.z = cvt_pk_bf16(f[12], f[13]); b2.w = cvt_pk_bf16(f[14], f[15]);
            bf16_t* dp = dst + (size_t)dr * K + k0 + seg * 16; *(u32x4*)dp = a; *(u32x4*)(dp + 8) = b2; } }
    __syncthreads();
}
__device__ __forceinline__ void phase_prep(KA ka, unsigned char* ws, LAS unsigned char* lds, int bid, int nb) {
    const int t = tidx();
    constexpr int T_IN = 16 * 241, T_GLU = 8 * 16, T_BR = 8 * 32, T_OUT = 16 * 32, T_L = T_IN + T_GLU + 3 * T_BR + T_OUT;
    for (int tile = bid; tile < DEPTH * T_L; tile += nb) {
        const int l = tile / T_L; int r = tile - l * T_L;
        if (r < T_IN) { cvt_tile(lds, PF(w_in) + (size_t)l * DM * NIN_SRC, DM, NIN_SRC, (bf16_t*)(ws + WS_WIN) + (size_t)l * NIN_T * DM, (r / 241) * 128, (r % 241) * 64, true); continue; }
        r -= T_IN;
        if (r < T_GLU) { cvt_tile(lds, PF(s5_wglu) + (size_t)l * 1024 * 1024, 1024, 1024, (bf16_t*)(ws + WS_WGLU) + (size_t)l * 1024 * 1024, (r / 16) * 128, (r % 16) * 64, false); continue; }
        r -= T_GLU;
        if (r < 3 * T_BR) { const int b = r / T_BR; r -= b * T_BR; const float* src = (b == 0 ? PF(w_br_ret) : (b == 1 ? PF(w_br_gla) : PF(w_br_s5))) + (size_t)l * 1024 * 2048;
            cvt_tile(lds, src, 1024, 2048, (bf16_t*)(ws + WS_WBR) + (size_t)(l * 3 + b) * 2048 * 1024, (r / 32) * 128, (r % 32) * 64, false); continue; }
        r -= 3 * T_BR;
        cvt_tile(lds, PF(w_out) + (size_t)l * 2048 * 2048, 2048, 2048, (bf16_t*)(ws + WS_WOUT) + (size_t)l * 2048 * 2048, (r / 32) * 128, (r % 32) * 64, false);
    }
    const size_t gtid = (size_t)bid * NT + t, gsz = (size_t)nb * NT;
    for (size_t i = gtid; i < (size_t)DEPTH * 240 * DM / 8; i += gsz) { const size_t l = i / (240 * DM / 8), o = i % (240 * DM / 8);
        *(u32x4*)((bf16_t*)(ws + WS_WIN) + (l * NIN_T + 15376) * DM + o * 8) = (u32x4){0u, 0u, 0u, 0u}; }
    { float* H = (float*)(ws + WS_H); bf16_t* HN = (bf16_t*)(ws + WS_HN); float* SS = (float*)(ws + WS_SS); const int wave = t >> 6, lane = t & 63;
        for (int r = bid * 8 + wave; r < MR; r += nb * 8) { f32x4 v[8]; float ss = 0.f;
#pragma unroll
            for (int j = 0; j < 8; ++j) { const int c = (j * 64 + lane) * 4; v[j] = (f32x4){0.f, 0.f, 0.f, 0.f};
                if (r >= 256) v[j] = *(const f32x4*)(PF(x) + (size_t)(r - 256) * DM + c); else if (r >= ROW0) v[j] = *(const f32x4*)(PF(meta) + (size_t)(r - ROW0) * DM + c);
                ss += v[j][0] * v[j][0] + v[j][1] * v[j][1] + v[j][2] * v[j][2] + v[j][3] * v[j][3]; }
#pragma unroll
            for (int o = 32; o >= 1; o >>= 1) ss += __shfl_xor(ss, o);
#pragma unroll
            for (int j = 0; j < 8; ++j) { const int c = (j * 64 + lane) * 4; const f32x4 gv = *(const f32x4*)(PF(norm_g) + c); const f32x4 o = v[j] * gv;
                *(f32x4*)(H + (size_t)r * DM + c) = v[j]; u32x2 w; w.x = cvt_pk_bf16(o[0], o[1]); w.y = cvt_pk_bf16(o[2], o[3]); *(u32x2*)(HN + (size_t)r * DM + c) = w; }
            SS[(size_t)r * 64 + lane] = lane == 0 ? ss : 0.f; } }
    float* cosT = (float*)(ws + WS_COS); float* sinT = (float*)(ws + WS_SIN);
    for (size_t i = gtid; i < (size_t)MR * 64; i += gsz) { const int pos = (int)(i >> 6), k = (int)(i & 63);
        const float inv = exp2f(-(float)k * (13.287712379549449f / 64.0f)); const float ang = (float)pos * inv; float s, c; sincos_red(ang, s, c); cosT[i] = c; sinT[i] = s; }
    for (size_t i = gtid; i < (size_t)128 * 1024 / 8; i += gsz) { const u32x4 z = (u32x4){0u, 0u, 0u, 0u};
        *(u32x4*)((bf16_t*)(ws + WS_RO) + i * 8) = z; *(u32x4*)((bf16_t*)(ws + WS_GO) + i * 8) = z; *(u32x4*)((bf16_t*)(ws + WS_SOPRE) + i * 8) = z; }
}

__device__ __forceinline__ void phase_rmsnorm(const float* H, const float* g, bf16_t* HN, int bid, int nb) {
    const int wave = tidx() >> 6, lane = tidx() & 63;
    for (int r = bid * 8 + wave; r < MR; r += nb * 8) {
        const float* hp = H + (size_t)r * DM; f32x4 v[8]; float ss = 0.f;
#pragma unroll
        for (int j = 0; j < 8; ++j) { v[j] = *(const f32x4*)(hp + (j * 64 + lane) * 4); ss += v[j][0] * v[j][0] + v[j][1] * v[j][1] + v[j][2] * v[j][2] + v[j][3] * v[j][3]; }
#pragma unroll
        for (int o = 32; o >= 1; o >>= 1) ss += __shfl_xor(ss, o);
        const float rs = rsqrtf(ss * (1.0f / DM) + EPS);
#pragma unroll
        for (int j = 0; j < 8; ++j) { const int c = (j * 64 + lane) * 4; const f32x4 gv = *(const f32x4*)(g + c); const f32x4 o = v[j] * rs * gv;
            u32x2 w; w.x = cvt_pk_bf16(o[0], o[1]); w.y = cvt_pk_bf16(o[2], o[3]); *(u32x2*)(HN + (size_t)r * DM + c) = w; }
    }
}
__device__ __forceinline__ void phase_final(const float* H, const float* part, const float* g, float* out, int bid, int nb, float eps) {
    const int wave = tidx() >> 6, lane = tidx() & 63;
    f32x4 gvv[8];
#pragma unroll
    for (int j = 0; j < 8; ++j) gvv[j] = *(const f32x4*)(g + (j * 64 + lane) * 4);
    for (int r = bid * 8 + wave; r < SEQ; r += nb * 8) {
        float ss = part[(size_t)(r + 256) * 64 + lane];
#pragma unroll
        for (int o = 32; o >= 1; o >>= 1) ss += __shfl_xor(ss, o);
        const float rs = rsqrtf(ss * (1.0f / DM) + EPS); const float* hp = H + (size_t)(r + 256) * DM;
        f32x4 v[8];
#pragma unroll
        for (int j = 0; j < 8; ++j) v[j] = *(const f32x4*)(hp + (j * 64 + lane) * 4);
#pragma unroll
        for (int j = 0; j < 8; ++j) { const int c = (j * 64 + lane) * 4; f32x4 o = v[j] * rs * gvv[j];
            if (TK) { for (int e = 0; e < 4; ++e) { const unsigned idx = (unsigned)(r * DM + c + e); o[e] += (__builtin_popcount(idx * 2654435761u) & 1) ? eps : -eps; } }
            *(f32x4*)(out + (size_t)r * DM + c) = o; }
    }
}

constexpr int P128 = 272;
constexpr int P256 = 528;
__device__ __forceinline__ void stage_tile(LAS unsigned char* img, int lp, const bf16_t* g, size_t gp, int ncols) {
    const int segs = ncols >> 3, total = 128 * segs;
    for (int i = tidx(); i < total; i += NT) { const int r = i / segs, s = i - r * segs;
        *(LAS u32x4*)(img + r * lp + s * 16) = *(const u32x4*)(g + (size_t)r * gp + s * 8); }
}
template <int NCOLS> __device__ __forceinline__ void stage_load(u32x4 (&v)[NCOLS / 32], const bf16_t* g, size_t gp) {
    constexpr int segs = NCOLS >> 3;
#pragma unroll
    for (int j = 0; j < NCOLS / 32; ++j) { const int i = tidx() + j * NT, r = i / segs, sg = i - r * segs; v[j] = *(const u32x4*)(g + (size_t)r * gp + sg * 8); }
}
template <int NCOLS> __device__ __forceinline__ void stage_store(const u32x4 (&v)[NCOLS / 32], LAS unsigned char* img, int lp) {
    constexpr int segs = NCOLS >> 3;
#pragma unroll
    for (int j = 0; j < NCOLS / 32; ++j) { const int i = tidx() + j * NT, r = i / segs, sg = i - r * segs; *(LAS u32x4*)(img + r * lp + sg * 16) = v[j]; }
}
__device__ __forceinline__ void stage_tile_kdec(LAS unsigned char* img, int lp, const bf16_t* g, size_t gp, float lg) {
    for (int i = tidx(); i < 128 * 16; i += NT) { const int r = i >> 4, s = i & 15; const float sc = __expf(lg * (float)(127 - r));
        const u32x4 w = *(const u32x4*)(g + (size_t)r * gp + s * 8); f32x4 a, b; unpack8(w, a, b); *(LAS u32x4*)(img + r * lp + s * 16) = pack8(a * sc, b * sc); }
}

__device__ __forceinline__ void gla_gate(KA ka, unsigned char* ws, int l, int n, int h, LAS float* glrS  , LAS float* segT  , float (&bl)[32], float& blast) {
    const int t = tidx(), d = t & 127, seg = t >> 7;
    const float* GLR = (const float*)(ws + WS_GLR);
    for (int i = t; i < 128 * 16 / 4; i += NT) *(LAS f32x4*)(glrS + i * 4) = *(const f32x4*)(GLR + (size_t)n * 128 * 16 + i * 4);
    float wa[16];
#pragma unroll
    for (int r = 0; r < 16; ++r) wa[r] = PF(gla_w_a)[((size_t)l * 16 + r) * 512 + h * 128 + d];
    const float ba = PF(gla_b_a)[(size_t)l * 512 + h * 128 + d];
    __syncthreads();
    float cum = 0.f;
#pragma unroll
    for (int i = 0; i < 32; ++i) { const int s = seg * 32 + i; float x = ba;
#pragma unroll
        for (int r4 = 0; r4 < 4; ++r4) { const f32x4 gv = *(const LAS f32x4*)(glrS + s * 16 + r4 * 4); x += gv[0] * wa[r4 * 4] + gv[1] * wa[r4 * 4 + 1] + gv[2] * wa[r4 * 4 + 2] + gv[3] * wa[r4 * 4 + 3]; }
        float la = logsigmoidf_(x) * (1.0f / 16.0f); if (n * 128 + s < ROW0) la = 0.f;
        cum += la; bl[i] = cum; }
    segT[seg * 128 + d] = cum;
    __syncthreads();
    float pre = 0.f, tot = 0.f;
#pragma unroll
    for (int k = 0; k < 4; ++k) { const float v = segT[k * 128 + d]; tot += v; if (k < seg) pre += v; }
#pragma unroll
    for (int i = 0; i < 32; ++i) bl[i] += pre;
    blast = tot;
}

__device__ __forceinline__ void ret_state_unit(KA ka, unsigned char* ws, LAS unsigned char* lds, int n, int h) {
    const int t = tidx(), w = t >> 6, lane = t & 63;
    const bf16_t* PJ = (const bf16_t*)(ws + WS_PROJ) + (size_t)n * 128 * PLD;
    LAS unsigned char* Kimg = lds; LAS unsigned char* Vimg = lds + 128 * P128;
    const float lg = ret_log_gamma(h);
    stage_tile_kdec(Kimg, P128, PJ + C_RK + h * 128, PLD, lg);
    stage_tile(Vimg, P128, PJ + C_RV + h * 128, PLD, 128);
    __syncthreads();
    const int d0 = (w >> 1) * 32, v0 = (w & 1) * 64;
    f32x4 acc[2][4];
#pragma unroll
    for (int a = 0; a < 2; ++a)
#pragma unroll
        for (int b = 0; b < 4; ++b) acc[a][b] = (f32x4){0.f, 0.f, 0.f, 0.f};
#pragma unroll
    for (int ks = 0; ks < 4; ++ks) { bf16x8 a[2], b[4];
#pragma unroll
        for (int mi = 0; mi < 2; ++mi) a[mi] = frag_tr(Kimg, P128, 32 * ks, d0 + 16 * mi, lane);
#pragma unroll
        for (int ni = 0; ni < 4; ++ni) b[ni] = frag_tr(Vimg, P128, 32 * ks, v0 + 16 * ni, lane);
#pragma unroll
        for (int mi = 0; mi < 2; ++mi)
#pragma unroll
            for (int ni = 0; ni < 4; ++ni) acc[mi][ni] = MFMA16(a[mi], b[ni], acc[mi][ni]); }
    float* KV = (float*)(ws + WS_RKV) + (size_t)(n * 8 + h) * 128 * 128;
#pragma unroll
    for (int mi = 0; mi < 2; ++mi)
#pragma unroll
        for (int ni = 0; ni < 4; ++ni)
#pragma unroll
            for (int r = 0; r < 4; ++r) KV[(d0 + 16 * mi + 4 * (lane >> 4) + r) * 128 + v0 + 16 * ni + (lane & 15)] = acc[mi][ni][r];
    __syncthreads();
}
__device__ __forceinline__ void gla_state_unit(KA ka, unsigned char* ws, LAS unsigned char* lds, int l, int n, int h) {
    const int t = tidx(), w = t >> 6, lane = t & 63, d = t & 127, seg = t >> 7;
    const bf16_t* PJ = (const bf16_t*)(ws + WS_PROJ) + (size_t)n * 128 * PLD;
    LAS unsigned char* Kimg = lds; LAS unsigned char* Vimg = lds + 128 * P128;
    LAS float* glrS = (LAS float*)(lds + 128 * P128 + 128 * P256); LAS float* segT = glrS + 128 * 16;
    u32x4 vt[8]; stage_load<256>(vt, PJ + C_GV + h * 256, PLD);
    bf16_t kraw[32];
#pragma unroll
    for (int i = 0; i < 32; ++i) kraw[i] = PJ[(size_t)(seg * 32 + i) * PLD + C_GK + h * 128 + d];
    float bl[32], blast;
    gla_gate(ka, ws, l, n, h, glrS, segT, bl, blast);
#pragma unroll
    for (int i = 0; i < 32; ++i) { const int s = seg * 32 + i; const float k = bf2f(kraw[i]);
        *(LAS bf16_t*)(Kimg + s * P128 + d * 2) = f2bf(k * __expf(blast - bl[i])); }
    if (seg == 0) ((float*)(ws + WS_GDEC))[(size_t)(n * 4 + h) * 128 + d] = __expf(blast);
    stage_store<256>(vt, Vimg, P256);
    __syncthreads();
    const int d0 = (w >> 2) * 64, v0 = (w & 3) * 64;
    f32x4 acc[4][4];
#pragma unroll
    for (int a = 0; a < 4; ++a)
#pragma unroll
        for (int b = 0; b < 4; ++b) acc[a][b] = (f32x4){0.f, 0.f, 0.f, 0.f};
#pragma unroll
    for (int ks = 0; ks < 4; ++ks) { bf16x8 a[4], b[4];
#pragma unroll
        for (int mi = 0; mi < 4; ++mi) a[mi] = frag_tr(Kimg, P128, 32 * ks, d0 + 16 * mi, lane);
#pragma unroll
        for (int ni = 0; ni < 4; ++ni) b[ni] = frag_tr(Vimg, P256, 32 * ks, v0 + 16 * ni, lane);
#pragma unroll
        for (int mi = 0; mi < 4; ++mi)
#pragma unroll
            for (int ni = 0; ni < 4; ++ni) acc[mi][ni] = MFMA16(a[mi], b[ni], acc[mi][ni]); }
    float* KV = (float*)(ws + WS_GKV) + (size_t)(n * 4 + h) * 128 * 256;
#pragma unroll
    for (int mi = 0; mi < 4; ++mi)
#pragma unroll
        for (int ni = 0; ni < 4; ++ni)
#pragma unroll
            for (int r = 0; r < 4; ++r) KV[(d0 + 16 * mi + 4 * (lane >> 4) + r) * 256 + v0 + 16 * ni + (lane & 15)] = acc[mi][ni][r];
    __syncthreads();
}

__device__ __forceinline__ void s5_disc(KA ka, int l, int g, int pp, float& ar, float& ai, float& fre, float& fim) {
    const float dt = __expf(PF(s5_logdt)[l * 64 + g]); const float lr = PF(s5_lre)[(size_t)(l * 64 + g) * 64 + pp], li = PF(s5_lim)[(size_t)(l * 64 + g) * 64 + pp];
    const float mag = __expf(lr * dt); float s, c; sincos_red(li * dt, s, c); ar = mag * c; ai = mag * s;
    const float den = lr * lr + li * li, nr = ar - 1.0f, ni = ai; fre = (nr * lr + ni * li) / den; fim = (ni * lr - nr * li) / den;
}
constexpr int S5_U = 0;
constexpr int S5_W = 128 * P128;
constexpr int S5_WB = 16 * 132 * 4 + 16 * P128;
__device__ __forceinline__ void s5_task(KA ka, unsigned char* ws, LAS unsigned char* lds, int l, int n, int j, int mode) {
    const int t = tidx(), w = t >> 6, lane = t & 63, l15 = lane & 15, g4 = lane >> 4, g = 8 * j + w;
    const bf16_t* PJ = (const bf16_t*)(ws + WS_PROJ) + (size_t)n * 128 * PLD;
    LAS unsigned char* Uimg = lds + S5_U; LAS float* BU = (LAS float*)(lds + S5_W + w * S5_WB); LAS unsigned char* Hw = lds + S5_W + w * S5_WB + 16 * 132 * 4;
    u32x4 ut[4]; stage_load<128>(ut, PJ + C_SU + 128 * j, PLD);
    bf16x8 bbf[8], cfr[4];
    { const size_t gb = (size_t)(l * 64 + g) * 64;
#pragma unroll
        for (int q = 0; q < 4; ++q) { const int pp = 16 * q + l15; float ar, ai, fre, fim; s5_disc(ka, l, g, pp, ar, ai, fre, fim);
            f32x4 br0 = (f32x4){0.f, 0.f, 0.f, 0.f}, br1 = br0, bi0 = br0, bi1 = br0;
            if (g4 < 2) { const float* pr = PF(s5_bre) + (gb + pp) * 16 + 8 * g4; const float* pi = PF(s5_bim) + (gb + pp) * 16 + 8 * g4;
                br0 = *(const f32x4*)pr; br1 = *(const f32x4*)(pr + 4); bi0 = *(const f32x4*)pi; bi1 = *(const f32x4*)(pi + 4); }
            const u32x4 re = pack8(br0 * fre - bi0 * fim, br1 * fre - bi1 * fim), im = pack8(bi0 * fre + br0 * fim, bi1 * fre + br1 * fim);
            bbf[q] = __builtin_bit_cast(bf16x8, re); bbf[4 + q] = __builtin_bit_cast(bf16x8, im); }
        const size_t cb = ((size_t)(l * 64 + g) * 16 + l15) * 64;
#pragma unroll
        for (int ks = 0; ks < 4; ++ks) { const float* pc = (ks < 2 ? PF(s5_cre) : PF(s5_cim)) + cb + 32 * (ks & 1) + 8 * g4; const float sg = ks < 2 ? 1.0f : -1.0f;
            const f32x4 c0 = *(const f32x4*)pc, c1 = *(const f32x4*)(pc + 4); cfr[ks] = __builtin_bit_cast(bf16x8, pack8(c0 * sg, c1 * sg)); } }
    float ar, ai; { float fre, fim; s5_disc(ka, l, g, lane, ar, ai, fre, fim); }
    float hr = 0.f, hi = 0.f;
    if (mode == 1) { const float* Hs = (const float*)(ws + WS_S5H) + ((size_t)(n * 64 + g) * 64 + lane) * 2; hr = Hs[0]; hi = Hs[1]; }
    const float dd = PF(s5_d)[(size_t)l * 1024 + g * 16 + l15];
    stage_store<128>(ut, Uimg, P128);
    __syncthreads();
#pragma unroll 1
    for (int sc = 0; sc < 8; ++sc) {
        const int t0 = 16 * sc;
        bf16x8 a = (bf16x8){0, 0, 0, 0, 0, 0, 0, 0};
        if (g4 < 2) a = *(const LAS bf16x8*)(Uimg + (t0 + l15) * P128 + (w * 16 + 8 * g4) * 2);
#pragma unroll
        for (int ni = 0; ni < 8; ++ni) { f32x4 acc = (f32x4){0.f, 0.f, 0.f, 0.f}; acc = MFMA16(a, bbf[ni], acc);
#pragma unroll
            for (int r = 0; r < 4; ++r) BU[(4 * g4 + r) * 132 + 16 * ni + l15] = acc[r]; }
        __syncthreads();
#pragma unroll
        for (int i = 0; i < 16; ++i) { const float bur = BU[i * 132 + lane], bui = BU[i * 132 + 64 + lane];
            const float nr = ar * hr - ai * hi + bur, ni = ar * hi + ai * hr + bui; hr = nr; hi = ni;
            if (mode == 1) { *(LAS bf16_t*)(Hw + i * P128 + lane * 2) = f2bf(hr); *(LAS bf16_t*)(Hw + i * P128 + (64 + lane) * 2) = f2bf(hi); } }
        if (mode == 1) {
            __syncthreads();
            f32x4 acc = (f32x4){0.f, 0.f, 0.f, 0.f};
#pragma unroll
            for (int ks = 0; ks < 4; ++ks) { const bf16x8 ha = frag_row(Hw, P128, 0, 32 * ks, lane); acc = MFMA16(ha, cfr[ks], acc); }
#pragma unroll
            for (int r = 0; r < 4; ++r) { LAS bf16_t* up = (LAS bf16_t*)(Uimg + (t0 + 4 * g4 + r) * P128 + (w * 16 + l15) * 2); const float u = bf2f(*up); *up = f2bf(geluf_(acc[r] + dd * u)); }
        }
    }
    if (mode == 0) { float* E = (float*)(ws + WS_S5E) + ((size_t)(n * 64 + g) * 64 + lane) * 2; E[0] = hr; E[1] = hi; }
    else { __syncthreads();
        bf16_t* SP = (bf16_t*)(ws + WS_SOPRE) + (size_t)n * 128 * 1024 + 128 * j;
        for (int i = t; i < 128 * 16; i += NT) { const int r = i >> 4, sgm = i & 15; *(u32x4*)(SP + (size_t)r * 1024 + sgm * 8) = *(const LAS u32x4*)(Uimg + r * P128 + sgm * 16); } }
    __syncthreads();
}

__device__ __forceinline__ void phase_scan(KA ka, unsigned char* ws, int l, int bid, int nb) {
    const size_t gtid = (size_t)bid * NT + tidx(), gsz = (size_t)nb * NT;
    { const float* KVr = (const float*)(ws + WS_RKV); bf16_t* PVr = (bf16_t*)(ws + WS_RPREV);
      const float* KVg = (const float*)(ws + WS_GKV); bf16_t* PVg = (bf16_t*)(ws + WS_GPREV); const float* DEC = (const float*)(ws + WS_GDEC);
        for (size_t e = gtid; e < (size_t)131072; e += gsz) {
            const int hr_ = (int)(e >> 14); const size_t dvr = e & 16383; const float g128 = __expf(ret_log_gamma(hr_) * 128.0f);
            const int hg = (int)(e >> 15); const size_t dvg = e & 32767; const int d = (int)(dvg >> 8);
            float pr = 0.f, pg = 0.f;
            float kr[2][13], kg[2][13], dc[2][13];
#pragma unroll
            for (int k = 0; k < 13; ++k) { const int n = 1 + k; kr[0][k] = KVr[(size_t)(n * 8 + hr_) * 16384 + dvr]; kg[0][k] = KVg[(size_t)(n * 4 + hg) * 32768 + dvg]; dc[0][k] = DEC[(size_t)(n * 4 + hg) * 128 + d]; }
#pragma unroll
            for (int b = 0; b < 5; ++b) {
                if (b < 4) {
#pragma unroll
                    for (int k = 0; k < 13; ++k) { const int n = 1 + 13 * (b + 1) + k; kr[(b + 1) & 1][k] = KVr[(size_t)(n * 8 + hr_) * 16384 + dvr]; kg[(b + 1) & 1][k] = KVg[(size_t)(n * 4 + hg) * 32768 + dvg]; dc[(b + 1) & 1][k] = DEC[(size_t)(n * 4 + hg) * 128 + d]; } }
#pragma unroll
                for (int k = 0; k < 13; ++k) { const int n = 1 + 13 * b + k; const size_t ir = (size_t)(n * 8 + hr_) * 16384 + dvr, ig = (size_t)(n * 4 + hg) * 32768 + dvg;
                    PVr[ir] = f2bf(pr); PVg[ig] = f2bf(pg); pr = g128 * pr + kr[b & 1][k]; pg = dc[b & 1][k] * pg + kg[b & 1][k]; } } } }
    { const float* E = (const float*)(ws + WS_S5E); float* Hs = (float*)(ws + WS_S5H);
        for (size_t e = gsz - 1 - gtid; e < (size_t)4096; e += gsz) { const int g = (int)(e >> 6), pp = (int)(e & 63); float ar, ai, fre, fim; s5_disc(ka, l, g, pp, ar, ai, fre, fim);
#pragma unroll
            for (int k = 0; k < 7; ++k) { const float nr = ar * ar - ai * ai, ni = 2.0f * ar * ai; ar = nr; ai = ni; }
            float hr = 0.f, hi = 0.f;
            for (int n0 = 1; n0 < NCH; n0 += 13) { float er[13], ei[13];
#pragma unroll
                for (int k = 0; k < 13; ++k) { const size_t idx = ((size_t)(n0 + k) * 4096 + e) * 2; er[k] = E[idx]; ei[k] = E[idx + 1]; }
#pragma unroll
                for (int k = 0; k < 13; ++k) { const size_t idx = ((size_t)(n0 + k) * 4096 + e) * 2; Hs[idx] = hr; Hs[idx + 1] = hi;
                    const float nr = ar * hr - ai * hi + er[k], ni = ar * hi + ai * hr + ei[k]; hr = nr; hi = ni; } } } }
}

constexpr int OFF_Q = 0, OFF_KS = 128 * P128, OFF_V = 2 * 128 * P128, OFF_P = 3 * 128 * P128, OFF_X = 4 * 128 * P128;
__device__ __forceinline__ void ret_out_unit(KA ka, unsigned char* ws, LAS unsigned char* lds, int l, int n, int h) {
    const int t = tidx(), w = t >> 6, lane = t & 63, g4 = lane >> 4, l15 = lane & 15;
    const bf16_t* PJ = (const bf16_t*)(ws + WS_PROJ) + (size_t)n * 128 * PLD;
    LAS unsigned char* Qimg = lds + OFF_Q; LAS unsigned char* KSimg = lds + OFF_KS; LAS unsigned char* Vimg = lds + OFF_V; LAS unsigned char* Pimg = lds + OFF_P;
    LAS float* RED = (LAS float*)(lds + OFF_X);
    const float lg = ret_log_gamma(h);
    float gtv[2][4][4], gnv[4];
#pragma unroll
    for (int ni = 0; ni < 4; ++ni) { const int v = (w & 1) * 64 + 16 * ni + l15; gnv[ni] = PF(ret_norm_g)[(size_t)l * 1024 + h * 128 + v];
#pragma unroll
        for (int mi = 0; mi < 2; ++mi)
#pragma unroll
            for (int r = 0; r < 4; ++r) gtv[mi][r][ni] = bf2f(PJ[(size_t)((w >> 1) * 32 + 16 * mi + 4 * g4 + r) * PLD + C_RG + h * 128 + v]); }
    stage_tile(Qimg, P128, PJ + C_RQ + h * 128, PLD, 128);
    stage_tile(KSimg, P128, PJ + C_RK + h * 128, PLD, 128);
    stage_tile(Vimg, P128, PJ + C_RV + h * 128, PLD, 128);
    stage_tile(Pimg, P128, (const bf16_t*)(ws + WS_RPREV) + (size_t)(n * 8 + h) * 16384, 128, 128);
    __syncthreads();
    const int c0 = (w >> 1) * 32, x0 = (w & 1) * 64;
    f32x4 sc[2][4];
#pragma unroll
    for (int a = 0; a < 2; ++a)
#pragma unroll
        for (int b = 0; b < 4; ++b) sc[a][b] = (f32x4){0.f, 0.f, 0.f, 0.f};
    if (x0 <= c0 + 31) {
#pragma unroll
        for (int ks = 0; ks < 4; ++ks) { bf16x8 a[2], b[4];
#pragma unroll
            for (int mi = 0; mi < 2; ++mi) a[mi] = frag_row(Qimg, P128, c0 + 16 * mi, 32 * ks, lane);
#pragma unroll
            for (int ni = 0; ni < 4; ++ni) b[ni] = frag_row(KSimg, P128, x0 + 16 * ni, 32 * ks, lane);
#pragma unroll
            for (int mi = 0; mi < 2; ++mi)
#pragma unroll
                for (int ni = 0; ni < 4; ++ni) sc[mi][ni] = MFMA16(a[mi], b[ni], sc[mi][ni]); } }
    __syncthreads();
#pragma unroll
    for (int mi = 0; mi < 2; ++mi)
#pragma unroll
        for (int ni = 0; ni < 4; ++ni)
#pragma unroll
            for (int r = 0; r < 4; ++r) { const int c = c0 + 16 * mi + 4 * g4 + r, s = x0 + 16 * ni + l15;
                const float v = (c >= s) ? sc[mi][ni][r] * __expf(lg * (float)(c - s)) : 0.f; *(LAS bf16_t*)(KSimg + c * P128 + s * 2) = f2bf(v); }
    __syncthreads();
    f32x4 a1[2][4], a2[2][4];
#pragma unroll
    for (int a = 0; a < 2; ++a)
#pragma unroll
        for (int b = 0; b < 4; ++b) { a1[a][b] = (f32x4){0.f, 0.f, 0.f, 0.f}; a2[a][b] = (f32x4){0.f, 0.f, 0.f, 0.f}; }
#pragma unroll
    for (int ks = 0; ks < 4; ++ks) { bf16x8 sa[2], qa[2], vb[4], pb[4];
#pragma unroll
        for (int mi = 0; mi < 2; ++mi) { sa[mi] = frag_row(KSimg, P128, c0 + 16 * mi, 32 * ks, lane); qa[mi] = frag_row(Qimg, P128, c0 + 16 * mi, 32 * ks, lane); }
#pragma unroll
        for (int ni = 0; ni < 4; ++ni) { vb[ni] = frag_tr(Vimg, P128, 32 * ks, x0 + 16 * ni, lane); pb[ni] = frag_tr(Pimg, P128, 32 * ks, x0 + 16 * ni, lane); }
#pragma unroll
        for (int mi = 0; mi < 2; ++mi)
#pragma unroll
            for (int ni = 0; ni < 4; ++ni) { a1[mi][ni] = MFMA16(sa[mi], vb[ni], a1[mi][ni]); a2[mi][ni] = MFMA16(qa[mi], pb[ni], a2[mi][ni]); } }
#pragma unroll
    for (int mi = 0; mi < 2; ++mi)
#pragma unroll
        for (int r = 0; r < 4; ++r) { const int c = c0 + 16 * mi + 4 * g4 + r; const float qd = __expf(lg * (float)(c + 1)); float s = 0.f, ss = 0.f;
#pragma unroll
            for (int ni = 0; ni < 4; ++ni) { const float o = a1[mi][ni][r] + qd * a2[mi][ni][r]; a1[mi][ni][r] = o; s += o; ss += o * o; }
#pragma unroll
            for (int o = 1; o <= 8; o <<= 1) { s += __shfl_xor(s, o); ss += __shfl_xor(ss, o); }
            if (l15 == 0) { RED[(c * 2 + (w & 1)) * 2] = s; RED[(c * 2 + (w & 1)) * 2 + 1] = ss; } }
    __syncthreads();
    bf16_t* RO = (bf16_t*)(ws + WS_RO);
#pragma unroll
    for (int mi = 0; mi < 2; ++mi)
#pragma unroll
        for (int r = 0; r < 4; ++r) { const int c = c0 + 16 * mi + 4 * g4 + r; const float s = RED[c * 4] + RED[c * 4 + 2], ss = RED[c * 4 + 1] + RED[c * 4 + 3];
            const float mu = s * (1.0f / 128.0f); const float var = fmaxf(ss * (1.0f / 128.0f) - mu * mu, 0.f); const float rstd = rsqrtf(var + EPS);
            const size_t row = (size_t)n * 128 + c;
#pragma unroll
            for (int ni = 0; ni < 4; ++ni) { const int v = x0 + 16 * ni + l15;
                RO[row * 1024 + h * 128 + v] = f2bf((a1[mi][ni][r] - mu) * rstd * gnv[ni] * gtv[mi][r][ni]); } }
    __syncthreads();
}
__device__ __forceinline__ void gla_out_unit(KA ka, unsigned char* ws, LAS unsigned char* lds, int l, int n, int h) {
    const int t = tidx(), w = t >> 6, lane = t & 63, g4 = lane >> 4, l15 = lane & 15, d = t & 127, seg = t >> 7;
    const bf16_t* PJ = (const bf16_t*)(ws + WS_PROJ) + (size_t)n * 128 * PLD;
    LAS unsigned char* Qimg = lds + OFF_Q; LAS unsigned char* KSimg = lds + OFF_KS; LAS unsigned char* Vimg = lds + OFF_V; LAS unsigned char* Pimg = lds + OFF_P;
    LAS float* glrS = (LAS float*)(lds + OFF_X); LAS float* segT = glrS + 128 * 16; LAS float* RED = segT + 4 * 128;
    const bf16_t* PV = (const bf16_t*)(ws + WS_GPREV) + (size_t)(n * 4 + h) * 32768;
    u32x4 vt[4], pt[4]; stage_load<128>(vt, PJ + C_GV + h * 256, PLD); stage_load<128>(pt, PV, 256);
    bf16_t qraw[32], kraw[32];
#pragma unroll
    for (int i = 0; i < 32; ++i) { qraw[i] = PJ[(size_t)(seg * 32 + i) * PLD + C_GQ + h * 128 + d]; kraw[i] = PJ[(size_t)(seg * 32 + i) * PLD + C_GK + h * 128 + d]; }
    { float bl[32], blast; gla_gate(ka, ws, l, n, h, glrS, segT, bl, blast);
#pragma unroll
        for (int i = 0; i < 32; ++i) { const int s = seg * 32 + i; const float q = bf2f(qraw[i]), k = bf2f(kraw[i]);
            *(LAS bf16_t*)(Qimg + s * P128 + d * 2) = f2bf(q * __expf(bl[i])); *(LAS bf16_t*)(KSimg + s * P128 + d * 2) = f2bf(k * __expf(-bl[i])); } }
    stage_store<128>(vt, Vimg, P128); stage_store<128>(pt, Pimg, P128);
    __syncthreads();
    stage_load<128>(vt, PJ + C_GV + h * 256 + 128, PLD); stage_load<128>(pt, PV + 128, 256);
    const int c0 = (w >> 1) * 32, x0 = (w & 1) * 64;
    f32x4 sc[2][4];
#pragma unroll
    for (int a = 0; a < 2; ++a)
#pragma unroll
        for (int b = 0; b < 4; ++b) sc[a][b] = (f32x4){0.f, 0.f, 0.f, 0.f};
    if (x0 <= c0 + 31) {
#pragma unroll
        for (int ks = 0; ks < 4; ++ks) { bf16x8 a[2], b[4];
#pragma unroll
            for (int mi = 0; mi < 2; ++mi) a[mi] = frag_row(Qimg, P128, c0 + 16 * mi, 32 * ks, lane);
#pragma unroll
            for (int ni = 0; ni < 4; ++ni) b[ni] = frag_row(KSimg, P128, x0 + 16 * ni, 32 * ks, lane);
#pragma unroll
            for (int mi = 0; mi < 2; ++mi)
#pragma unroll
                for (int ni = 0; ni < 4; ++ni) sc[mi][ni] = MFMA16(a[mi], b[ni], sc[mi][ni]); } }
    __syncthreads();
#pragma unroll
    for (int mi = 0; mi < 2; ++mi)
#pragma unroll
        for (int ni = 0; ni < 4; ++ni)
#pragma unroll
            for (int r = 0; r < 4; ++r) { const int c = c0 + 16 * mi + 4 * g4 + r, s = x0 + 16 * ni + l15;
                const float v = (c >= s) ? sc[mi][ni][r] : 0.f; *(LAS bf16_t*)(KSimg + c * P128 + s * 2) = f2bf(v); }
    __syncthreads();
    f32x4 oa[2][2][4];
#pragma unroll
    for (int hf = 0; hf < 2; ++hf) {
        if (hf == 1) { __syncthreads(); stage_store<128>(vt, Vimg, P128); stage_store<128>(pt, Pimg, P128); __syncthreads(); }
#pragma unroll
        for (int a = 0; a < 2; ++a)
#pragma unroll
            for (int b = 0; b < 4; ++b) oa[hf][a][b] = (f32x4){0.f, 0.f, 0.f, 0.f};
#pragma unroll
        for (int ks = 0; ks < 4; ++ks) { bf16x8 sa[2], qa[2], vb[4], pb[4];
#pragma unroll
            for (int mi = 0; mi < 2; ++mi) { sa[mi] = frag_row(KSimg, P128, c0 + 16 * mi, 32 * ks, lane); qa[mi] = frag_row(Qimg, P128, c0 + 16 * mi, 32 * ks, lane); }
#pragma unroll
            for (int ni = 0; ni < 4; ++ni) { vb[ni] = frag_tr(Vimg, P128, 32 * ks, x0 + 16 * ni, lane); pb[ni] = frag_tr(Pimg, P128, 32 * ks, x0 + 16 * ni, lane); }
#pragma unroll
            for (int mi = 0; mi < 2; ++mi)
#pragma unroll
                for (int ni = 0; ni < 4; ++ni) { oa[hf][mi][ni] = MFMA16(sa[mi], vb[ni], oa[hf][mi][ni]); oa[hf][mi][ni] = MFMA16(qa[mi], pb[ni], oa[hf][mi][ni]); } }
    }
    float gtv[2][2][4][4], gnv[2][4];
#pragma unroll
    for (int hf = 0; hf < 2; ++hf)
#pragma unroll
        for (int ni = 0; ni < 4; ++ni) { const int v = hf * 128 + x0 + 16 * ni + l15; gnv[hf][ni] = PF(gla_norm_g)[(size_t)l * 256 + v];
#pragma unroll
            for (int mi = 0; mi < 2; ++mi)
#pragma unroll
                for (int r = 0; r < 4; ++r) gtv[hf][mi][r][ni] = bf2f(PJ[(size_t)(c0 + 16 * mi + 4 * g4 + r) * PLD + C_GG + h * 256 + v]); }
#pragma unroll
    for (int mi = 0; mi < 2; ++mi)
#pragma unroll
        for (int r = 0; r < 4; ++r) { const int c = c0 + 16 * mi + 4 * g4 + r; float ss = 0.f;
#pragma unroll
            for (int hf = 0; hf < 2; ++hf)
#pragma unroll
                for (int ni = 0; ni < 4; ++ni) { const float o = oa[hf][mi][ni][r]; ss += o * o; }
#pragma unroll
            for (int o = 1; o <= 8; o <<= 1) ss += __shfl_xor(ss, o);
            if (l15 == 0) RED[c * 2 + (w & 1)] = ss; }
    __syncthreads();
    bf16_t* GO = (bf16_t*)(ws + WS_GO);
#pragma unroll
    for (int mi = 0; mi < 2; ++mi)
#pragma unroll
        for (int r = 0; r < 4; ++r) { const int c = c0 + 16 * mi + 4 * g4 + r; const float ss = RED[c * 2] + RED[c * 2 + 1]; const float rstd = rsqrtf(ss * (1.0f / 256.0f) + EPS);
            const size_t row = (size_t)n * 128 + c;
#pragma unroll
            for (int hf = 0; hf < 2; ++hf)
#pragma unroll
                for (int ni = 0; ni < 4; ++ni) { const int v = hf * 128 + x0 + 16 * ni + l15;
                    GO[row * 1024 + h * 256 + v] = f2bf(oa[hf][mi][ni][r] * rstd * gnv[hf][ni] * gtv[hf][mi][r][ni]); } }
    __syncthreads();
}

constexpr int U_GLA = 65 * 4, U_RET = 65 * 8, U_S5 = 65 * 8, U_ALL = U_GLA + U_RET + U_S5;
__device__ __forceinline__ int unit_of(int b, int k, int nb) {
    if (nb != 256) { const int u = b + k * nb; return u < U_ALL ? u : -1; }
    const int j = b - 4;
    if (k == 0) return b;
    if (k == 1) return b < 4 ? 256 + b : -1;
    if (k < 5) { const int i = k - 2; int r;
        if (b < 4) r = i == 0 ? b : -1;
        else if (j < 12) r = i == 0 ? 4 + j : -1;
        else if (j < 36) r = 16 + 3 * (j - 12) + i;
        else r = i < 2 ? 88 + 2 * (j - 36) + i : -1;
        return r < 0 ? -1 : U_GLA + r; }
    if (k < 8) { const int i = k - 5; int q;
        if (b < 4) q = i == 0 ? b : -1;
        else if (j < 12) q = 4 + 3 * j + i;
        else if (j < 36) q = i < 2 ? 40 + 2 * (j - 12) + i : -1;
        else q = i < 2 ? 88 + 2 * (j - 36) + i : -1;
        return q < 0 ? -1 : U_GLA + U_RET + q; }
    return -1;
}
__device__ __forceinline__ void phase_states(KA ka, unsigned char* ws, LAS unsigned char* lds, int l, int bid, int nb) {
    const int nslots = nb == 256 ? 8 : (U_ALL + nb - 1) / nb;
    for (int k = 0; k < nslots; ++k) { const int u = unit_of(bid, k, nb); if (u < 0) continue;
        if (u < U_GLA) gla_state_unit(ka, ws, lds, l, 1 + u / 4, u % 4);
        else if (u < U_GLA + U_RET) { const int v = u - U_GLA; ret_state_unit(ka, ws, lds, 1 + v / 8, v % 8); }
        else { const int v = u - U_GLA - U_RET; s5_task(ka, ws, lds, l, 1 + v / 8, v % 8, 0); }
    }
}
__device__ __forceinline__ void phase_outputs(KA ka, unsigned char* ws, LAS unsigned char* lds, int l, int bid, int nb) {
    const int nslots = nb == 256 ? 8 : (U_ALL + nb - 1) / nb;
    for (int k = 0; k < nslots; ++k) { const int u = unit_of(bid, k, nb); if (u < 0) continue;
        if (u < U_GLA) gla_out_unit(ka, ws, lds, l, 1 + u / 4, u % 4);
        else if (u < U_GLA + U_RET) { const int v = u - U_GLA; ret_out_unit(ka, ws, lds, l, 1 + v / 8, v % 8); }
        else { const int v = u - U_GLA - U_RET; s5_task(ka, ws, lds, l, 1 + v / 8, v % 8, 1); }
    }
}

__global__ void __launch_bounds__(NT) mega(Params p) {
    extern __shared__ __attribute__((aligned(16))) unsigned char lds_raw[];
    LAS unsigned char* lds = (LAS unsigned char*)lds_raw;
    cg::grid_group grid = cg::this_grid();
    const int bid = blockIdx.x, nb = gridDim.x;
    KA ka = (KA)__builtin_amdgcn_kernarg_segment_ptr();
    unsigned char* ws = PF(ws);
#define FRESH() do { int z_ = 0; asm volatile("" : "+v"(z_)); const int zz_ = __builtin_amdgcn_readfirstlane(z_); ka = (KA)__builtin_amdgcn_kernarg_segment_ptr() + zz_; ws = PF(ws) + zz_; } while (0)
#define WSP(T, off) ((T*)(ws + (off)))

    volatile LAS unsigned* st = (volatile LAS unsigned*)(lds + LDS_BYTES - 16);
    if (tidx() == 0) { st[0] = 0u; st[1] = 0u; }
    __syncthreads();
    (void)xcd_barrier_post((unsigned*)(PF(ws) + WS_BAR), st);
#define STAMP(k) do { if (TK && bid == 0 && tidx() == 0) ((unsigned long long*)(PF(ws) + WS_STAMP))[k] = __builtin_amdgcn_s_memrealtime(); } while (0)
    STAMP(0);
#define GSYNC() do { XcdBarrier b_; b_.bar = (unsigned*)(PF(ws) + WS_BAR); b_.x = xb_xcc_id(); b_.st = (volatile LAS unsigned*)(lds + LDS_BYTES - 16); xcd_barrier(b_); } while (0)
    FRESH(); phase_prep(ka, ws, lds, bid, nb);
    grid.sync(); STAMP(1);
    for (int l = 0; l < DEPTH; ++l) {
        FRESH();
        { const bf16_t* HN = WSP(const bf16_t, WS_HN); const bf16_t* W = WSP(const bf16_t, WS_WIN) + (size_t)l * NIN_T * DM;
            pg8::Gemm g{HN, W, 0, 0, MR, NIN_T, DM}; pg8::StaticOrder S; S.init(MR, NIN_T, nb, bid, 1);
            EpiIn E{WSP(bf16_t, WS_PROJ), WSP(float, WS_GLR), WSP(const float, WS_COS), WSP(const float, WS_SIN), WSP(const float, WS_SS) + (size_t)l * MR * 64};
            pg8::gemm_phase<EpiIn>(lds, g, S, E); }
        GSYNC(); STAMP(2 + 7 * l + 0);
        FRESH(); phase_states(ka, ws, lds, l, bid, nb);
        GSYNC(); STAMP(2 + 7 * l + 1);
        FRESH(); phase_scan(ka, ws, l, bid, nb);
        GSYNC(); STAMP(2 + 7 * l + 2);
        FRESH(); phase_outputs(ka, ws, lds, l, bid, nb);
        GSYNC(); STAMP(2 + 7 * l + 3);
        FRESH();
        { const bf16_t* A = WSP(const bf16_t, WS_SOPRE); const bf16_t* W = WSP(const bf16_t, WS_WGLU) + (size_t)l * 1024 * 1024;
            pg8::Gemm g{A, W, 0, 0, SEQ, 1024, 1024}; pg8::StaticOrder S; S.init(SEQ, 1024, nb, bid, 1, 1);
            EpiGlu E{A, WSP(const bf16_t, WS_PROJ), WSP(bf16_t, WS_SO)};
            skinny_phase<EpiGlu>(lds, A, W, 0, 0, 1024, 1024, 0, 1, E, (bid + nb - 128) % nb, nb);
            { const bf16_t* Wb = WSP(const bf16_t, WS_WBR) + (size_t)l * 3 * 2048 * 1024; EpiBr Eb{WSP(const bf16_t, WS_PROJ), WSP(float, WS_YACC), WSP(bf16_t, WS_Y)};
              skinny_phase<EpiBr>(lds, WSP(const bf16_t, WS_RO), Wb, WS_GO - WS_RO, (size_t)2048 * 1024 * 2, 1024, 2048, 0, 2, Eb, (bid + nb - 160) % nb, nb); }
            pg8::gemm_phase<EpiGlu>(lds, g, S, E); }
        GSYNC(); STAMP(2 + 7 * l + 4);
        FRESH();
        { const bf16_t* W = WSP(const bf16_t, WS_WBR) + (size_t)l * 3 * 2048 * 1024;
            pg8::Gemm g{WSP(const bf16_t, WS_RO), W, WS_GO - WS_RO, (size_t)2048 * 1024 * 2, MR, 2048, 1024};
            static_assert(WS_SO - WS_GO == WS_GO - WS_RO, "branch inputs must be equally spaced");
            pg8::StaticOrder S; S.init(SEQ, 2048, nb, bid, 3, 1);
            EpiBr E{WSP(const bf16_t, WS_PROJ), WSP(float, WS_YACC), WSP(bf16_t, WS_Y)};
            skinny_phase<EpiBr>(lds, g.A, g.Bt, g.selA, g.selB, 1024, 2048, 2, 3, E, bid, nb);
            pg8::gemm_phase<EpiBr>(lds, g, S, E); }
        GSYNC(); STAMP(2 + 7 * l + 5);
        FRESH();
        { const bf16_t* A = WSP(const bf16_t, WS_Y); const bf16_t* W = WSP(const bf16_t, WS_WOUT) + (size_t)l * 2048 * 2048;
            pg8::Gemm g{A, W, 0, 0, SEQ, 2048, 2048}; pg8::StaticOrder S; S.init(SEQ, 2048, nb, bid, 1, 1);
            EpiOut E{WSP(float, WS_H), WSP(bf16_t, WS_HN), l + 1 < DEPTH ? PF(norm_g) + (size_t)(l + 1) * DM : (const float*)nullptr, WSP(float, WS_SS) + (size_t)(l + 1) * MR * 64};
            skinny_phase<EpiOut>(lds, A, W, 0, 0, 2048, 2048, 0, 1, E, bid, nb);
            pg8::gemm_phase<EpiOut>(lds, g, S, E); }
        GSYNC(); STAMP(2 + 7 * l + 6);
    }
    FRESH(); float eps = 0.f;
    if (TK) { const unsigned long long* st_ = (const unsigned long long*)(ws + WS_STAMP); eps = sqrtf(5e-8f * 0.01f * (float)(st_[TK] - st_[TK0])); }
    phase_final(WSP(const float, WS_H), WSP(const float, WS_SS) + (size_t)DEPTH * MR * 64, PF(final_g), PF(out), bid, nb, eps);
}

extern "C" void kernel_launch(void* const* d_in, const int* in_sizes, int n_in, void* d_out, int out_size, void* d_ws, size_t ws_size, hipStream_t stream) {
    static int grid = 0;
    if (grid == 0) {
        if (n_in != 22 || ws_size < WS_END) { fprintf(stderr, "kernel_launch: unexpected inputs (n_in %d) or workspace too small (%zu < %zu)\n", n_in, ws_size, (size_t)WS_END); grid = -1; return; }
        int dev = 0, cus = 0, per_cu = 0;
        hipGetDevice(&dev); hipDeviceGetAttribute(&cus, hipDeviceAttributeMultiprocessorCount, dev);
        if (hipFuncSetAttribute((const void*)mega, hipFuncAttributeMaxDynamicSharedMemorySize, LDS_BYTES) != hipSuccess) { fprintf(stderr, "kernel_launch: hipFuncSetAttribute failed\n"); grid = -1; return; }
        if (hipOccupancyMaxActiveBlocksPerMultiprocessor(&per_cu, (const void*)mega, NT, LDS_BYTES) != hipSuccess || per_cu < 1) { fprintf(stderr, "kernel_launch: occupancy query gave %d\n", per_cu); per_cu = 1; (void)hipGetLastError(); }
        grid = cus * per_cu;
    }
    if (grid < 0) return;
    Params p{};
    const float** f = (const float**)&p;
    for (int i = 0; i < 22; ++i) f[i] = (const float*)d_in[i];
    p.out = (float*)d_out; p.ws = (unsigned char*)d_ws;
    if (hipMemsetAsync((char*)d_ws + WS_BAR, 0, 3456 * 4 + 2 * DEPTH * 256, stream) != hipSuccess) { fprintf(stderr, "kernel_launch: memset failed\n"); return; }
    void* args[] = {&p};
    hipError_t e = hipLaunchCooperativeKernel((const void*)mega, dim3(grid), dim3(NT), args, LDS_BYTES, stream);
    if (e != hipSuccess) fprintf(stderr, "cooperative launch failed: %s (grid %d)\n", hipGetErrorString(e), grid);
}
```
